# Optimizing an MI355X kernel written in HIP

```python
import math
import jax
import jax.numpy as jnp
from jax import lax
import numpy as np

D_MODEL = 2048
BATCH = 4
SEQ = 2048
DEPTH = 2

CTX_LEN = 256
GRID_W = 64
N_DENSE_LAYERS = (DEPTH + 1) // 2
N_MOE_LAYERS = DEPTH // 2
EPS = 1e-6

POOL_WINDOWS = (2, 4, 8, 16)
POOL_GROUPS = len(POOL_WINDOWS)
POOL_WIDTH = D_MODEL // 2
POOL_GROUP_DIM = POOL_WIDTH // POOL_GROUPS
SGU_WIDTH = D_MODEL // 2
SGU_GROUPS = 8
SGU_GROUP_DIM = SGU_WIDTH // SGU_GROUPS
CHUNK = 128
DIFF_HEADS = D_MODEL // 256
DIFF_QK_DIM = 64
DIFF_V_DIM = 2 * DIFF_QK_DIM
DIFF_WIDTH = DIFF_HEADS * DIFF_V_DIM
ROPE_BASE = 10000.0
Q_BLOCK = 128
N_BRANCHES = 3
OFF_A = 0
OFF_B = OFF_A + POOL_WIDTH
OFF_Q = OFF_B + 2 * SGU_WIDTH
OFF_K = OFF_Q + DIFF_HEADS * 2 * DIFF_QK_DIM
OFF_V = OFF_K + DIFF_HEADS * 2 * DIFF_QK_DIM
OFF_G = OFF_V + DIFF_WIDTH
IN_WIDTH = OFF_G + N_BRANCHES * D_MODEL
D_FF = 5632
N_EXPERTS = 8
TOP_K = 2
D_FF_EXPERT = D_MODEL * 7 // 2

kernel_name = 'hybrid_pool_sgu_diffattn_moe_dit'


def rms_norm(x, g):
    xf = x.astype(jnp.float32)
    y = xf * lax.rsqrt(jnp.mean(xf * xf, axis=-1, keepdims=True) + EPS)
    return (y * g.astype(jnp.float32)).astype(x.dtype)


def layer_norm(x, g):
    xf = x.astype(jnp.float32)
    mu = jnp.mean(xf, axis=-1, keepdims=True)
    var = jnp.mean(jnp.square(xf - mu), axis=-1, keepdims=True)
    return ((xf - mu) * lax.rsqrt(var + EPS) * g.astype(jnp.float32)).astype(x.dtype)


def modulate(h, shift, scale):
    return h * (1 + scale) + shift


def axial_rope_tables(rows):
    half = DIFF_QK_DIM // 2
    inv_freq = jnp.power(ROPE_BASE, -jnp.arange(0, half, 2, dtype=jnp.float32) / half)
    row = jnp.repeat(jnp.arange(rows, dtype=jnp.float32), GRID_W)
    col = jnp.tile(jnp.arange(GRID_W, dtype=jnp.float32), rows)
    ang_r = row[:, None] * inv_freq[None, :]
    ang_c = col[:, None] * inv_freq[None, :]
    ang = jnp.concatenate([ang_r, ang_r, ang_c, ang_c], axis=-1)
    return jnp.cos(ang), jnp.sin(ang)


def rotate_half(y):
    y1, y2 = jnp.split(y, 2, axis=-1)
    return jnp.concatenate([-y2, y1], axis=-1)


def apply_axial_rope(x, cos, sin):
    xr, xc = jnp.split(x, 2, axis=-1)
    rotated = jnp.concatenate([rotate_half(xr), rotate_half(xc)], axis=-1)
    return x * cos.astype(x.dtype) + rotated * sin.astype(x.dtype)


def multiscale_pool(a, w_pool, pool_scale):
    B, S, _ = a.shape
    af = a.astype(jnp.float32)
    cs = jnp.concatenate([jnp.zeros((B, 1, POOL_WIDTH), jnp.float32), jnp.cumsum(af, axis=1)], axis=1)
    t = jnp.arange(S)
    outs = []
    for g, w in enumerate(POOL_WINDOWS):
        lo = jnp.clip(t - w // 2, 0, S)
        hi = jnp.clip(t + w - w // 2, 0, S)
        sl = slice(g * POOL_GROUP_DIM, (g + 1) * POOL_GROUP_DIM)
        csg = cs[..., sl]
        cnt = (hi - lo).astype(jnp.float32)[None, :, None]
        outs.append((csg[:, hi] - csg[:, lo]) / cnt - af[..., sl])
    pooled = jnp.stack(outs, axis=2).astype(a.dtype)
    mixed = jnp.einsum('bsgc,gcd->bsgd', pooled, w_pool)
    return mixed.reshape(B, S, POOL_WIDTH) * pool_scale


def chunk_sgu(z, norm_g, w_s, b_s):
    B, S, _ = z.shape
    z = jax.nn.gelu(z)
    u, v = z[..., :SGU_WIDTH], z[..., SGU_WIDTH:]
    v = layer_norm(v, norm_g)
    v = v.reshape(B, S // CHUNK, CHUNK, SGU_GROUPS, SGU_GROUP_DIM)
    mixed = jnp.einsum('gpq,bnqgc->bnpgc', w_s, v) + b_s.T[None, None, :, :, None]
    return u * mixed.reshape(B, S, SGU_WIDTH)


def qk_heads(cols):
    B, S, _ = cols.shape
    return cols.reshape(B, S, DIFF_HEADS, 2, DIFF_QK_DIM).transpose(3, 0, 2, 1, 4)


def v_heads(cols):
    B, S, _ = cols.shape
    return cols.reshape(B, S, DIFF_HEADS, DIFF_V_DIM).transpose(0, 2, 1, 3)


def diff_attend(q, k, v, lam):
    _, B, H, Sq, dh = q.shape
    nb = Sq // Q_BLOCK
    scale = 1.0 / math.sqrt(DIFF_QK_DIM)
    qb = q.reshape(2, B, H, nb, Q_BLOCK, dh).transpose(3, 0, 1, 2, 4, 5)

    def one_block(qblk):
        s = jnp.einsum('ibhqd,ibhkd->ibhqk', qblk, k).astype(jnp.float32) * scale
        p = jax.nn.softmax(s, axis=-1)
        a = p[0] - lam * p[1]
        return jnp.einsum('bhqk,bhkd->bhqd', a.astype(v.dtype), v)

    o = lax.map(one_block, qb)
    return o.transpose(1, 2, 0, 3, 4).reshape(B, H, Sq, DIFF_V_DIM)


def diff_output(o, subln_g, lambda_init):
    B, H, S, _ = o.shape
    o = rms_norm(o, subln_g) * (1.0 - lambda_init)
    return o.transpose(0, 2, 1, 3).reshape(B, S, DIFF_WIDTH)


def merge_branches(p, a_out, b_out, c_out, w_pa, w_pb, w_pc, w_o):
    g = jax.nn.sigmoid(p[..., OFF_G:])
    ga, gb, gc = g[..., :D_MODEL], g[..., D_MODEL:2 * D_MODEL], g[..., 2 * D_MODEL:]
    merged = ga * (a_out @ w_pa) + gb * (b_out @ w_pb) + gc * (c_out @ w_pc)
    return merged @ w_o


def swiglu(h, w1, w3, w2):
    return (jax.nn.silu(h @ w1) * (h @ w3)) @ w2


def moe_swiglu(h, w_router, w1, w3, w2):
    logits = (h @ w_router).astype(jnp.float32)
    top_vals, top_idx = lax.top_k(logits, TOP_K)
    weights = jax.nn.softmax(top_vals, axis=-1)
    combine = jnp.sum(jax.nn.one_hot(top_idx, N_EXPERTS, dtype=jnp.float32) * weights[..., None], axis=-2)
    out = jnp.zeros_like(h)
    for e in range(N_EXPERTS):
        out = out + combine[..., e:e + 1].astype(h.dtype) * swiglu(h, w1[e], w3[e], w2[e])
    return out


def setup_inputs(seed: int = 0) -> dict:
    key = jax.random.key(seed)
    ks = iter(jax.random.split(key, 40))

    def nrm(shape, scale):
        return jax.random.normal(next(ks), shape, jnp.float32) * scale

    L, D = DEPTH, D_MODEL
    return {
        'x': nrm((BATCH, SEQ, D), 1.0),
        'c': nrm((BATCH, D), 1.0),
        'ctx': nrm((BATCH, CTX_LEN, D), 1.0),
        'c_ctx': nrm((D,), 1.0),
        'w_mod': nrm((L, D, 6 * D), 0.5 * D ** -0.5),
        'b_mod': nrm((L, 6 * D), 0.02),
        'norm1_g': 1.0 + nrm((L, D), 0.1),
        'norm2_g': 1.0 + nrm((L, D), 0.1),
        'w_in': nrm((L, D, IN_WIDTH), D ** -0.5),
        'pool_w': nrm((L, POOL_GROUPS, POOL_GROUP_DIM, POOL_GROUP_DIM), POOL_GROUP_DIM ** -0.5),
        'pool_scale': 1.0 + nrm((L, POOL_WIDTH), 0.1),
        'sgu_norm_g': 1.0 + nrm((L, SGU_WIDTH), 0.1),
        'sgu_w': nrm((L, SGU_GROUPS, CHUNK, CHUNK), CHUNK ** -0.5),
        'sgu_b': 1.0 + nrm((L, SGU_GROUPS, CHUNK), 0.1),
        'lambda_q1': nrm((L, DIFF_QK_DIM), 0.1),
        'lambda_k1': nrm((L, DIFF_QK_DIM), 0.1),
        'lambda_q2': nrm((L, DIFF_QK_DIM), 0.1),
        'lambda_k2': nrm((L, DIFF_QK_DIM), 0.1),
        'attn_subln_g': 1.0 + nrm((L, DIFF_V_DIM), 0.1),
        'w_proj_a': nrm((L, POOL_WIDTH, D), POOL_WIDTH ** -0.5),
        'w_proj_b': nrm((L, SGU_WIDTH, D), SGU_WIDTH ** -0.5),
        'w_proj_c': nrm((L, DIFF_WIDTH, D), DIFF_WIDTH ** -0.5),
        'w_o': nrm((L, D, D), D ** -0.5),
        'ffn_w1': nrm((N_DENSE_LAYERS, D, D_FF), D ** -0.5),
        'ffn_w3': nrm((N_DENSE_LAYERS, D, D_FF), D ** -0.5),
        'ffn_w2': nrm((N_DENSE_LAYERS, D_FF, D), D_FF ** -0.5),
        'moe_router': nrm((N_MOE_LAYERS, D, N_EXPERTS), D ** -0.5),
        'moe_w1': nrm((N_MOE_LAYERS, N_EXPERTS, D, D_FF_EXPERT), D ** -0.5),
        'moe_w3': nrm((N_MOE_LAYERS, N_EXPERTS, D, D_FF_EXPERT), D ** -0.5),
        'moe_w2': nrm((N_MOE_LAYERS, N_EXPERTS, D_FF_EXPERT, D), D_FF_EXPERT ** -0.5),
        'final_norm_g': 1.0 + nrm((D,), 0.1),
    }


def reference(x, c, ctx, c_ctx, w_mod, b_mod, norm1_g, norm2_g, w_in, pool_w, pool_scale,
              sgu_norm_g, sgu_w, sgu_b, lambda_q1, lambda_k1, lambda_q2, lambda_k2, attn_subln_g,
              w_proj_a, w_proj_b, w_proj_c, w_o, ffn_w1, ffn_w3, ffn_w2,
              moe_router, moe_w1, moe_w3, moe_w2, final_norm_g):
    S = x.shape[1]
    ROWS = S // GRID_W
    cos, sin = axial_rope_tables(ROWS)

    for l in range(DEPTH):
        last = l == DEPTH - 1
        lambda_init = 0.8 - 0.6 * math.exp(-0.3 * l)
        mod = jax.nn.silu(c) @ w_mod[l] + b_mod[l]
        sh1, sc1, gt1, sh2, sc2, gt2 = jnp.split(mod[:, None, :], 6, axis=-1)
        mod_c = jax.nn.silu(c_ctx) @ w_mod[l] + b_mod[l]
        csh1, csc1, cgt1, csh2, csc2, cgt2 = jnp.split(mod_c, 6, axis=-1)
        lam = (jnp.exp(jnp.sum(lambda_q1[l] * lambda_k1[l]).astype(jnp.float32))
               - jnp.exp(jnp.sum(lambda_q2[l] * lambda_k2[l]).astype(jnp.float32)) + lambda_init)

        h = modulate(rms_norm(x, norm1_g[l]), sh1, sc1)
        hc = modulate(rms_norm(ctx, norm1_g[l]), csh1, csc1)
        p = h @ w_in[l]
        q = apply_axial_rope(qk_heads(p[..., OFF_Q:OFF_K]), cos, sin)
        k = apply_axial_rope(qk_heads(p[..., OFF_K:OFF_V]), cos, sin)
        v = v_heads(p[..., OFF_V:OFF_G])
        if last:
            pc_kv = hc @ w_in[l][:, OFF_K:OFF_G]
            kc = qk_heads(pc_kv[..., :OFF_V - OFF_K])
            vc = v_heads(pc_kv[..., OFF_V - OFF_K:])
        else:
            pc = hc @ w_in[l]
            kc = qk_heads(pc[..., OFF_K:OFF_V])
            vc = v_heads(pc[..., OFF_V:OFF_G])
        k_all = jnp.concatenate([k, kc], axis=3)
        v_all = jnp.concatenate([v, vc], axis=2)
        c_out = diff_output(diff_attend(q, k_all, v_all, lam), attn_subln_g[l], lambda_init)
        a_out = multiscale_pool(p[..., OFF_A:OFF_B], pool_w[l], pool_scale[l])
        b_out = chunk_sgu(p[..., OFF_B:OFF_Q], sgu_norm_g[l], sgu_w[l], sgu_b[l])
        x = x + gt1 * merge_branches(p, a_out, b_out, c_out, w_proj_a[l], w_proj_b[l], w_proj_c[l], w_o[l])
        if not last:
            qc = qk_heads(pc[..., OFF_Q:OFF_K])
            cc_out = diff_output(diff_attend(qc, kc, vc, lam), attn_subln_g[l], lambda_init)
            ac_out = multiscale_pool(pc[..., OFF_A:OFF_B], pool_w[l], pool_scale[l])
            bc_out = chunk_sgu(pc[..., OFF_B:OFF_Q], sgu_norm_g[l], sgu_w[l], sgu_b[l])
            ctx = ctx + cgt1 * merge_branches(pc, ac_out, bc_out, cc_out,
                                              w_proj_a[l], w_proj_b[l], w_proj_c[l], w_o[l])

        h2 = modulate(rms_norm(x, norm2_g[l]), sh2, sc2)
        if l % 2 == 0:
            e = l // 2
            x = x + gt2 * swiglu(h2, ffn_w1[e], ffn_w3[e], ffn_w2[e])
            if not last:
                hc2 = modulate(rms_norm(ctx, norm2_g[l]), csh2, csc2)
                ctx = ctx + cgt2 * swiglu(hc2, ffn_w1[e], ffn_w3[e], ffn_w2[e])
        else:
            e = l // 2
            x = x + gt2 * moe_swiglu(h2, moe_router[e], moe_w1[e], moe_w3[e], moe_w2[e])
            if not last:
                hc2 = modulate(rms_norm(ctx, norm2_g[l]), csh2, csc2)
                ctx = ctx + cgt2 * moe_swiglu(hc2, moe_router[e], moe_w1[e], moe_w3[e], moe_w2[e])

    return rms_norm(x, final_norm_g)
```

```cpp
#include <hip/hip_runtime.h>
#include <cstdio>
#include <cstdint>

#ifndef MK_N_LAUNCHES
#define MK_N_LAUNCHES 1
#endif

#define LAS __attribute__((address_space(3)))
#define GAS __attribute__((address_space(1)))
typedef unsigned short bf16;
typedef short bf16x8 __attribute__((ext_vector_type(8)));
typedef short s16x4 __attribute__((ext_vector_type(4)));
typedef float f32x4 __attribute__((ext_vector_type(4)));
typedef float f32x2 __attribute__((ext_vector_type(2)));
typedef float f32x16 __attribute__((ext_vector_type(16)));
typedef unsigned u32x4 __attribute__((ext_vector_type(4)));
typedef unsigned u32x2 __attribute__((ext_vector_type(2)));
typedef int i32x8 __attribute__((ext_vector_type(8)));
typedef int i32x4 __attribute__((ext_vector_type(4)));

constexpr int DM = 2048, NB = 4, SEQ = 2048, CTXL = 256;
constexpr int MLAT = NB * SEQ, MCTX = NB * CTXL, MTOT = MLAT + MCTX;
constexpr int INW = 12288, OFF_A = 0, OFF_B = 1024, OFF_Q = 3072, OFF_K = 4096, OFF_V = 5120, OFF_G = 6144;
constexpr int DFF = 5632, NE = 8, DFE = 7168;
constexpr int NHEAD = 8;
constexpr float EPS = 1e-6f;
constexpr int MOE_ROWS = 2 * MLAT + NE * 256;
constexpr int MOE_TILES = MOE_ROWS / 256;

constexpr size_t MiB = 1u << 20;
constexpr size_t WS_CTL = 0, CTL_ZERO_BYTES = 1 * MiB;
constexpr size_t WS_MOD = 1 * MiB;
constexpr size_t WS_WIN = 2 * MiB;
constexpr size_t WS_WPC = WS_WIN + 96 * MiB;
constexpr size_t WS_WO = WS_WPC + 24 * MiB;
constexpr size_t WS_WPOOL = WS_WO + 16 * MiB;
constexpr size_t WS_W13 = WS_WPOOL + 1 * MiB;
constexpr size_t WS_W2 = WS_W13 + 44 * MiB;
constexpr size_t WS_MW13 = WS_W2 + 22 * MiB;
constexpr size_t WS_MW2 = WS_MW13 + 448 * MiB;
constexpr size_t WS_X = WS_MW2 + 224 * MiB;
constexpr size_t WS_H = WS_X + 72 * MiB;
constexpr size_t WS_P = WS_H + 36 * MiB;
constexpr size_t WS_POOLED = WS_P + 216 * MiB;
constexpr size_t WS_CAT = WS_POOLED + 18 * MiB;
constexpr size_t WS_MERGED = WS_CAT + 54 * MiB;
constexpr size_t WS_ACT = WS_MERGED + 36 * MiB;
constexpr size_t WS_ASORT = WS_ACT + 99 * MiB;
constexpr size_t WS_YSORT = WS_ASORT + 72 * MiB;
constexpr size_t WS_TOK = WS_YSORT + 144 * MiB;
constexpr size_t WS_H8 = WS_TOK + 1 * MiB;
constexpr size_t WS_WIN8 = WS_H8 + 18 * MiB;
constexpr size_t WS_END = WS_WIN8 + 36 * MiB;
constexpr size_t WS_ACTS = WS_P;
static_assert((size_t)MOE_ROWS * DFE * 2 <= 288 * MiB, "ACT_sorted overlay");
constexpr size_t TOK_E = 0, TOK_W = 65536, TOK_SLOT = 131072, TOK_CNT = 196608, TOK_INFO = 204800;

constexpr int CW_BAR = 4096;

constexpr int LDS_BYTES = 147456;
constexpr int MISC_OFF = LDS_BYTES - 2048;
constexpr int NWAVES = 8;

__device__ __forceinline__ unsigned cvt_pk_bf16(float lo, float hi) { unsigned r; asm volatile("v_cvt_pk_bf16_f32 %0, %1, %2" : "=v"(r) : "v"(lo), "v"(hi)); return r; }
__device__ __forceinline__ bf16x8 as_bf16x8(i32x4 v) { return __builtin_bit_cast(bf16x8, v); }
__device__ __forceinline__ float bf_lo(unsigned w) { return __uint_as_float(w << 16); }
__device__ __forceinline__ float bf_hi(unsigned w) { return __uint_as_float(w & 0xffff0000u); }
__device__ __forceinline__ float bf2f(bf16 b) { return __uint_as_float(((unsigned)b) << 16); }
template <int CTRL> __device__ __forceinline__ float dpp_xadd(float v) {
    return v + __builtin_bit_cast(float, __builtin_amdgcn_update_dpp(0, __builtin_bit_cast(int, v), CTRL, 0xf, 0xf, false));
}
__device__ __forceinline__ float row16_sum(float v) {
    v = dpp_xadd<0xB1>(v);
    v = dpp_xadd<0x4E>(v);
    v = dpp_xadd<0x141>(v);
    v = dpp_xadd<0x140>(v);
    return v;
}
__device__ __forceinline__ float wave_sum(float v) {
    const int r = __builtin_bit_cast(int, row16_sum(v));
    const float s0 = __builtin_bit_cast(float, __builtin_amdgcn_readlane(r, 0)),  s1 = __builtin_bit_cast(float, __builtin_amdgcn_readlane(r, 16));
    const float s2 = __builtin_bit_cast(float, __builtin_amdgcn_readlane(r, 32)), s3 = __builtin_bit_cast(float, __builtin_amdgcn_readlane(r, 48));
    return (s0 + s1) + (s2 + s3);
}
__device__ __forceinline__ float sigmoid_f(float x) { return __builtin_amdgcn_rcpf(1.0f + __builtin_amdgcn_exp2f(-1.4426950408889634f * x)); }
__device__ __forceinline__ float gelu_tanh_f(float x) { const float u = 0.7978845608028654f * (x + 0.044715f * x * x * x); return x * __builtin_amdgcn_rcpf(1.0f + __builtin_amdgcn_exp2f(-2.8853900817779268f * u)); }
constexpr float FP8_SA = 8.0f, FP8_SW = 64.0f, FP8_INV = 1.0f / (FP8_SA * FP8_SW);
#ifndef F8_MASK
#define F8_MASK 95
#endif
constexpr bool F8_GATES = (F8_MASK & 16) != 0;
constexpr bool F8_QKV = (F8_MASK & 64) != 0;
constexpr int IN_SPLIT = F8_QKV ? 3072 : 6144;
constexpr bool F8_FFN1 = (F8_MASK & 1) != 0, F8_FFN2 = (F8_MASK & 2) != 0, F8_MOE1 = (F8_MASK & 4) != 0, F8_MOE2 = (F8_MASK & 8) != 0;
__device__ __forceinline__ float clamp448(float x) { return __builtin_fminf(__builtin_fmaxf(x, -448.0f), 448.0f); }
__device__ __forceinline__ unsigned pk4_fp8(float a, float b, float c, float d) {
    int v = __builtin_amdgcn_cvt_pk_fp8_f32(clamp448(a), clamp448(b), 0, false); v = __builtin_amdgcn_cvt_pk_fp8_f32(clamp448(c), clamp448(d), v, true); return (unsigned)v; }
#define LDS_WAIT() asm volatile("s_waitcnt lgkmcnt(0)" ::: "memory")
#define VM_WAIT() asm volatile("s_waitcnt vmcnt(0)" ::: "memory")

namespace pg8 {
constexpr int BM = 256, BK = 64, HALF = 128, HTB = HALF * BK * 2, STAGE_BYTES = 8 * HTB, NXCD = 8, WGM = 8;
__host__ __device__ __forceinline__ int lds_byte(int r, int c) { const int st = (r >> 4) * 2 + (c >> 5), rr = r & 15, cc = c & 31, ob = rr * 64 + cc * 2; return st * 1024 + (ob ^ (((ob >> 9) & 1) << 5)); }
__host__ __device__ __forceinline__ void stage_rc(int b, int& R, int& C) { const int st = b / 1024, sb = b % 1024, swz = sb ^ (((sb >> 9) & 1) << 5); R = (st >> 1) * 16 + swz / 64; C = (st & 1) * 32 + (swz % 64) / 2; }
__host__ __device__ __forceinline__ int perm32(int rho) { const int n = rho >> 4, i = rho & 15; return 8 * (i >> 2) + 4 * n + (i & 3); }

struct Unit { const char* A; const char* B; int pm, pn; };

struct Order {
    int nM, nN, nwg, G, c;
    const char* A; const char* B; long aTile, bTile, aPn;
    int xM0, xNm, xN0, xCnt;
    const LAS int* tileE; long bExp;
    int skip;
    int kShift; long kOff;
    __device__ __forceinline__ void init(int nM_, int nN_, int G_, int c_, const void* A_, long aTile_, const void* B_, long bTile_) {
        nM = nM_; nN = nN_; nwg = nM_ * nN_; G = G_; c = c_; A = (const char*)A_; B = (const char*)B_; aTile = aTile_; bTile = bTile_; aPn = 0; xM0 = 0; xNm = 1; xN0 = 0; xCnt = 0; tileE = nullptr; bExp = 0; kShift = 30; kOff = 0; skip = 0; }
    __device__ __forceinline__ bool next(int i, Unit& u) const {
        long L = (long)i * G + c;
        if (skip > 0 && i >= 2) { if (c < skip) return false; L = 2L * G + (long)(i - 2) * (G - skip) + (c - skip); }
        if (L >= (long)nwg + xCnt) return false;
        int pm, pn;
        if (L < nwg) {
            int wgid = (int)L; { const int q = nwg / NXCD, r = nwg % NXCD, xcd = wgid % NXCD, off = wgid / NXCD; wgid = (xcd < r ? xcd * (q + 1) : r * (q + 1) + (xcd - r) * q) + off; }
            const int nig = WGM * nN, gid = wgid / nig, fm = gid * WGM, gsz = (nM - fm) < WGM ? (nM - fm) : WGM;
            pm = fm + ((wgid % nig) % gsz); pn = (wgid % nig) / gsz;
        } else { const int j = (int)(L - nwg); pm = xM0 + j / xNm; pn = xN0 + j % xNm; }
        const int ks = pn >> kShift, pnr = pn & ((1 << kShift) - 1);
        u.pm = pm; u.pn = pn; u.A = A + (long)pm * aTile + (long)pn * aPn + ks * kOff;
        long bo = (long)pnr * bTile + ks * kOff; if (tileE) bo += (long)__builtin_amdgcn_readfirstlane(tileE[pm]) * bExp;
        u.B = B + bo; return true;
    }
};

template <class Epi, class Sched, bool ALIGN_EPI, bool HOOK, bool FP8 = false>
__device__ __forceinline__ void gemm_phase(LAS unsigned char* lds, const int Kb, const int ldaB, const int ldbB, const Sched& S, const Epi& E) {
    int tid = threadIdx.x; asm volatile("" : "+v"(tid));
    const int wid = __builtin_amdgcn_readfirstlane(tid >> 6), lane = tid & 63, wr = wid >> 2, wc = wid & 3, fr = lane & 15, fq = lane >> 4;
    const int nt = Kb / (BK * 2);
    unsigned voffA[2], voffB[2];
#pragma unroll
    for (int i = 0; i < 2; ++i) { int R, C; stage_rc(tid * 16 + i * 8192, R, C); const int Rb = Epi::PERM ? ((R & ~31) + perm32(R & 31)) : R;
        voffA[i] = (unsigned)(R * ldaB + C * 2); voffB[i] = (unsigned)(Rb * ldbB + C * 2); }
    const size_t kstep = (size_t)(BK * 2);
    const size_t hstepA = (size_t)HALF * ldaB, hstepB = (size_t)HALF * ldbB;
    const unsigned ldsbase = (unsigned)__builtin_amdgcn_readfirstlane((int)(unsigned)(uintptr_t)lds + wid * 1024);
    const int aoff = lds_byte(wr * 64 + fr, fq * 8), boff = lds_byte(wc * 32 + fr, fq * 8);
#define PG8_SA(b, h) (((b) * 2 + (h)) * HTB)
#define PG8_SB(b, h) ((4 + (b) * 2 + (h)) * HTB)
#define PG8_STAGE(bufoff, gbase, voff) do { _Pragma("unroll") for (int _i = 0; _i < 2; ++_i) { unsigned _keep; \
        asm volatile("s_mov_b32 %0, m0\n\ts_mov_b32 m0, %3\n\ts_nop 0\n\tglobal_load_lds_dwordx4 %1, %2\n\ts_mov_b32 m0, %0" : "=&s"(_keep) : "v"((voff)[_i]), "s"((const char*)(gbase)), \
                     "s"(ldsbase + (unsigned)((bufoff) + _i * 8192)) : "memory"); } } while (0)
#define PG8_LDA(dst, b, h) do { _Pragma("unroll") for (int m = 0; m < 4; ++m) { dst[m].lo = *(const LAS i32x4*)(lds + PG8_SA(b, h) + aoff + m * 2048); dst[m].hi = *(const LAS i32x4*)(lds + PG8_SA(b, h) + aoff + m * 2048 + 1024); } } while (0)
#define PG8_LDB(dst, b, h) do { _Pragma("unroll") for (int n = 0; n < 2; ++n) { dst[n].lo = *(const LAS i32x4*)(lds + PG8_SB(b, h) + boff + n * 2048); dst[n].hi = *(const LAS i32x4*)(lds + PG8_SB(b, h) + boff + n * 2048 + 1024); } } while (0)
#define PG8_MMA(ai, bj, At, Bt) do { __builtin_amdgcn_s_setprio(3); _Pragma("unroll") for (int m = 0; m < 4; ++m) _Pragma("unroll") for (int n = 0; n < 2; ++n) { \
        if constexpr (FP8) asm volatile("v_mfma_f32_16x16x128_f8f6f4 %0, %1, %2, %0" : "+v"(acc[ai][bj][m][n]) : "v"(Bt[n]), "v"(At[m]));   \
        else { acc[ai][bj][m][n] = __builtin_amdgcn_mfma_f32_16x16x32_bf16(as_bf16x8(Bt[n].lo), as_bf16x8(At[m].lo), acc[ai][bj][m][n], 0, 0, 0); \
               acc[ai][bj][m][n] = __builtin_amdgcn_mfma_f32_16x16x32_bf16(as_bf16x8(Bt[n].hi), as_bf16x8(At[m].hi), acc[ai][bj][m][n], 0, 0, 0); } } \
        __builtin_amdgcn_s_setprio(0); } while (0)
#define PG8_WAIT_V(n) asm volatile("s_waitcnt vmcnt(" #n ")" ::: "memory")
#define PG8_WAIT_L(n) asm volatile("s_waitcnt lgkmcnt(" #n ")" ::: "memory")
#define PG8_BAR __builtin_amdgcn_s_barrier()
#define PG8_SCHED __builtin_amdgcn_sched_barrier(0)
    Unit cur, nxt; int ui = 0;
    if (!S.next(0, cur)) return;
    f32x4 acc[2][2][4][2];
#pragma unroll
    for (int a = 0; a < 2; ++a)
#pragma unroll
        for (int b = 0; b < 2; ++b)
#pragma unroll
            for (int m = 0; m < 4; ++m)
#pragma unroll
                for (int n = 0; n < 2; ++n) acc[a][b][m][n] = (f32x4){0.f, 0.f, 0.f, 0.f};
    i32x8 At[4], B0[2], B1[2];
    const char* cA = cur.A; const char* cB = cur.B;
    PG8_STAGE(PG8_SB(0, 0), cB, voffB); PG8_STAGE(PG8_SB(0, 1), cB + hstepB, voffB); PG8_STAGE(PG8_SA(0, 0), cA, voffA); PG8_STAGE(PG8_SA(0, 1), cA + hstepA, voffA);
    if (wr == 1) PG8_BAR;
    PG8_WAIT_V(2); PG8_BAR;
    PG8_STAGE(PG8_SB(1, 0), cB + kstep, voffB); PG8_STAGE(PG8_SA(1, 0), cA + kstep, voffA); PG8_STAGE(PG8_SB(1, 1), cB + hstepB + kstep, voffB);
    PG8_WAIT_V(6); PG8_BAR;
    for (;;) {
        const bool has_next = S.next(ui + 1, nxt);
        const char* nA = has_next ? nxt.A : cA; const char* nB = has_next ? nxt.B : cB;
        for (int t = 0; t < nt; t += 2) {
            const bool last = (t == nt - 2);
            const char* a1 = cA + (size_t)(t + 1) * kstep;
            const char* a2 = last ? nA : cA + (size_t)(t + 2) * kstep; const char* b2 = last ? nB : cB + (size_t)(t + 2) * kstep;
            const char* a3 = a2 + kstep; const char* b3 = b2 + kstep;
            if constexpr (HOOK) { if (t == 16 || t == 32) E.scale(acc, cur, t >> 4, wr, wc, fr, fq); }
            PG8_LDB(B0, 0, 0); PG8_LDB(B1, 0, 1); PG8_SCHED; PG8_LDA(At, 0, 0); PG8_STAGE(PG8_SA(1, 1), a1 + hstepA, voffA);
            PG8_WAIT_V(8); PG8_WAIT_L(0); PG8_BAR; PG8_MMA(0, 0, At, B0); PG8_MMA(0, 1, At, B1); PG8_BAR; PG8_SCHED;
            PG8_LDA(At, 0, 1); PG8_STAGE(PG8_SB(0, 0), b2, voffB); PG8_STAGE(PG8_SB(0, 1), b2 + hstepB, voffB); PG8_STAGE(PG8_SA(0, 0), a2, voffA);
            PG8_WAIT_V(8); PG8_WAIT_L(0); PG8_BAR; PG8_MMA(1, 0, At, B0); PG8_MMA(1, 1, At, B1); PG8_BAR; PG8_SCHED;
            PG8_LDB(B0, 1, 0); PG8_LDB(B1, 1, 1); PG8_SCHED; PG8_LDA(At, 1, 0); PG8_STAGE(PG8_SA(0, 1), a2 + hstepA, voffA);
            PG8_WAIT_V(8); PG8_WAIT_L(0); PG8_BAR; PG8_MMA(0, 0, At, B0); PG8_MMA(0, 1, At, B1); PG8_BAR; PG8_SCHED;
            PG8_LDA(At, 1, 1); PG8_STAGE(PG8_SB(1, 0), b3, voffB); PG8_STAGE(PG8_SB(1, 1), b3 + hstepB, voffB); PG8_STAGE(PG8_SA(1, 0), a3, voffA);
            PG8_WAIT_V(8); PG8_WAIT_L(0); PG8_BAR; PG8_MMA(1, 0, At, B0); PG8_MMA(1, 1, At, B1); PG8_BAR; PG8_SCHED;
        }
        if constexpr (ALIGN_EPI) { if (wr == 0) PG8_BAR; }
        if constexpr (FP8) asm volatile("s_nop 15\n\ts_nop 15\n\ts_nop 15\n\ts_nop 15\n\ts_nop 15" ::: "memory");
        E(acc, cur, wr, wc, fr, fq);
        if (!has_next) break;
#pragma unroll
        for (int a = 0; a < 2; ++a)
#pragma unroll
            for (int b = 0; b < 2; ++b)
#pragma unroll
                for (int m = 0; m < 4; ++m)
#pragma unroll
                    for (int n = 0; n < 2; ++n) acc[a][b][m][n] = (f32x4){0.f, 0.f, 0.f, 0.f};
        cur = nxt; cA = nA; cB = nB; ++ui;
        if constexpr (ALIGN_EPI) { if (wr == 1) PG8_BAR; }
    }
    PG8_WAIT_V(0);
    if constexpr (!ALIGN_EPI) { if (wr == 0) PG8_BAR; }
    PG8_BAR;
#undef PG8_SA
#undef PG8_SB
#undef PG8_STAGE
#undef PG8_LDA
#undef PG8_LDB
#undef PG8_MMA
#undef PG8_WAIT_V
#undef PG8_WAIT_L
#undef PG8_BAR
#undef PG8_SCHED
}

struct EpiInProj {
    static constexpr bool PERM = true;
    bf16* P; int pn_off; float ascale;
    __device__ __forceinline__ void operator()(const f32x4 (&acc)[2][2][4][2], const Unit& u, int wr, int wc, int fr, int fq) const {
        const int pn = u.pn + pn_off, pm = u.pm;
        const float asc = ascale * ((pn >= OFF_Q / 256 && pn < OFF_K / 256) ? 0.18033688011112042f : 1.0f);
        const int row0 = pm * BM + wr * 64 + fr, col0 = pn * BM + wc * 32 + 8 * fq;
        int kind = pn < 4 ? 0 : (pn < 12 ? 1 : (pn < 20 ? 2 : (pn < 24 ? 0 : 3)));
        if (kind == 2 && pm >= MLAT / BM) kind = 0;
        if (kind == 2) {
            const float sgn = (fq < 2) ? -1.f : 1.f;
            float fi[8];
#pragma unroll
            for (int i = 0; i < 8; ++i) fi[i] = __builtin_amdgcn_exp2f(-(float)(8 * (fq & 1) + i) * 0.83048202372184059f) * 0.15915494309189535f;
#pragma unroll
            for (int ai = 0; ai < 2; ++ai)
#pragma unroll
                for (int m = 0; m < 4; ++m) {
                    const int row = row0 + ai * HALF + m * 16, s = row & (SEQ - 1);
                    const float pos = (float)((wc & 1) ? (s & 63) : (s >> 6));
                    float cs[8], sn[8];
#pragma unroll
                    for (int i = 0; i < 8; ++i) { float rev = pos * fi[i]; rev = rev - __builtin_floorf(rev); cs[i] = __builtin_amdgcn_cosf(rev); sn[i] = __builtin_amdgcn_sinf(rev); }
                    bf16* rowp = P + (size_t)row * INW + col0;
#pragma unroll
                    for (int bj = 0; bj < 2; ++bj) {
                        float v[8], o[8];
#pragma unroll
                        for (int i = 0; i < 4; ++i) { v[i] = acc[ai][bj][m][0][i] * asc; v[4 + i] = acc[ai][bj][m][1][i] * asc; }
#pragma unroll
                        for (int i = 0; i < 8; ++i) { const float pr = __shfl_xor(v[i], 32); o[i] = v[i] * cs[i] + sgn * pr * sn[i]; }
                        u32x4 w; w.x = cvt_pk_bf16(o[0], o[1]); w.y = cvt_pk_bf16(o[2], o[3]); w.z = cvt_pk_bf16(o[4], o[5]); w.w = cvt_pk_bf16(o[6], o[7]);
                        *(u32x4*)(rowp + bj * HALF) = w;
                    }
                }
        } else {
#pragma unroll
            for (int ai = 0; ai < 2; ++ai)
#pragma unroll
                for (int m = 0; m < 4; ++m) { bf16* rowp = P + (size_t)(row0 + ai * HALF + m * 16) * INW + col0;
#pragma unroll
                    for (int bj = 0; bj < 2; ++bj) { f32x4 v0 = acc[ai][bj][m][0] * asc, v1 = acc[ai][bj][m][1] * asc;
                        if (kind == 1) {
#pragma unroll
                            for (int i = 0; i < 4; ++i) { v0[i] = gelu_tanh_f(v0[i]); v1[i] = gelu_tanh_f(v1[i]); } }
                        else if (kind == 3) {
#pragma unroll
                            for (int i = 0; i < 4; ++i) { v0[i] = sigmoid_f(v0[i]); v1[i] = sigmoid_f(v1[i]); } }
                        u32x4 w; w.x = cvt_pk_bf16(v0[0], v0[1]); w.y = cvt_pk_bf16(v0[2], v0[3]); w.z = cvt_pk_bf16(v1[0], v1[1]); w.w = cvt_pk_bf16(v1[2], v1[3]);
                        *(u32x4*)(rowp + bj * HALF) = w; } }
        }
    }
};
struct EpiScaleBf16 {
    static constexpr bool PERM = true;
    bf16* O; int ldc; const float* scale;
    __device__ __forceinline__ void operator()(const f32x4 (&acc)[2][2][4][2], const Unit& u, int wr, int wc, int fr, int fq) const {
        const int row0 = u.pm * BM + wr * 64 + fr, col0 = u.pn * BM + wc * 32 + 8 * fq;
        f32x4 sv[2][2];
#pragma unroll
        for (int bj = 0; bj < 2; ++bj)
#pragma unroll
            for (int n = 0; n < 2; ++n) sv[bj][n] = *(const f32x4*)(scale + col0 + bj * HALF + 4 * n);
#pragma unroll
        for (int ai = 0; ai < 2; ++ai)
#pragma unroll
            for (int m = 0; m < 4; ++m) { bf16* rowp = O + (size_t)(row0 + ai * HALF + m * 16) * ldc + col0;
#pragma unroll
                for (int bj = 0; bj < 2; ++bj) { const f32x4 v0 = acc[ai][bj][m][0] * sv[bj][0], v1 = acc[ai][bj][m][1] * sv[bj][1];
                    u32x4 w; w.x = cvt_pk_bf16(v0[0], v0[1]); w.y = cvt_pk_bf16(v0[2], v0[3]); w.z = cvt_pk_bf16(v1[0], v1[1]); w.w = cvt_pk_bf16(v1[2], v1[3]);
                    *(u32x4*)(rowp + bj * HALF) = w; } }
    }
};
struct EpiMerge {
    static constexpr bool PERM = true;
    const bf16* Pg;
    bf16* O;
    __device__ __forceinline__ void scale(f32x4 (&acc)[2][2][4][2], const Unit& u, int seg, int wr, int wc, int fr, int fq) const {
        int row0 = u.pm * BM + wr * 64 + fr; const int col0 = u.pn * BM + wc * 32 + 8 * fq;
        asm volatile("" : "+v"(row0));
        const bf16* gn = Pg + (size_t)(seg - 1) * DM + col0; const bf16* gd = Pg + (size_t)seg * DM + col0;
#pragma unroll
        for (int ai = 0; ai < 2; ++ai) {
#pragma unroll
            for (int m = 0; m < 4; ++m) { const size_t ro = (size_t)(row0 + ai * HALF + m * 16) * INW;
#pragma unroll
                for (int bj = 0; bj < 2; ++bj) { const u32x4 a = *(const u32x4*)(gn + ro + bj * HALF), b = *(const u32x4*)(gd + ro + bj * HALF);
                    f32x4 r0, r1;
                    r0[0] = bf_lo(a.x) * __builtin_amdgcn_rcpf(bf_lo(b.x)); r0[1] = bf_hi(a.x) * __builtin_amdgcn_rcpf(bf_hi(b.x));
                    r0[2] = bf_lo(a.y) * __builtin_amdgcn_rcpf(bf_lo(b.y)); r0[3] = bf_hi(a.y) * __builtin_amdgcn_rcpf(bf_hi(b.y));
                    r1[0] = bf_lo(a.z) * __builtin_amdgcn_rcpf(bf_lo(b.z)); r1[1] = bf_hi(a.z) * __builtin_amdgcn_rcpf(bf_hi(b.z));
                    r1[2] = bf_lo(a.w) * __builtin_amdgcn_rcpf(bf_lo(b.w)); r1[3] = bf_hi(a.w) * __builtin_amdgcn_rcpf(bf_hi(b.w));
                    acc[ai][bj][m][0] *= r0; acc[ai][bj][m][1] *= r1; }
                if (m == 3) asm volatile("" ::: "memory"); } }
    }
    __device__ __forceinline__ void operator()(const f32x4 (&acc)[2][2][4][2], const Unit& u, int wr, int wc, int fr, int fq) const {
        int row0 = u.pm * BM + wr * 64 + fr; const int col0 = u.pn * BM + wc * 32 + 8 * fq;
        asm volatile("" : "+v"(row0));
        const bf16* gc = Pg + (size_t)2 * DM + col0;
#pragma unroll
        for (int ai = 0; ai < 2; ++ai)
#pragma unroll
            for (int m = 0; m < 4; ++m) { const size_t r = (size_t)(row0 + ai * HALF + m * 16);
#pragma unroll
                for (int bj = 0; bj < 2; ++bj) { const u32x4 g = *(const u32x4*)(gc + r * INW + bj * HALF); const f32x4 v0 = acc[ai][bj][m][0], v1 = acc[ai][bj][m][1];
                    u32x4 w; w.x = cvt_pk_bf16(v0[0] * bf_lo(g.x), v0[1] * bf_hi(g.x)); w.y = cvt_pk_bf16(v0[2] * bf_lo(g.y), v0[3] * bf_hi(g.y));
                    w.z = cvt_pk_bf16(v1[0] * bf_lo(g.z), v1[1] * bf_hi(g.z)); w.w = cvt_pk_bf16(v1[2] * bf_lo(g.w), v1[3] * bf_hi(g.w));
                    *(u32x4*)(O + r * DM + col0 + bj * HALF) = w; } }
    }
};
struct EpiResid {
    static constexpr bool PERM = false;
    const float* src0; const float* src1; float* out; const float* gate; float ascale;
    __device__ __forceinline__ void operator()(const f32x4 (&acc)[2][2][4][2], const Unit& u, int wr, int wc, int fr, int fq) const {
        const int row0 = u.pm * BM + wr * 64 + fr, col0 = u.pn * BM + wc * 32 + 4 * fq;
        const bool isctx = u.pm >= MLAT / BM;
        const int bidx = isctx ? NB : (u.pm * BM) / SEQ;
        const float* src = isctx ? (src1 - (size_t)MLAT * DM) : src0;
        const float* gp = gate + (size_t)bidx * INW + col0;
        f32x4 gv[2][2];
#pragma unroll
        for (int bj = 0; bj < 2; ++bj)
#pragma unroll
            for (int n = 0; n < 2; ++n) gv[bj][n] = *(const f32x4*)(gp + bj * HALF + n * 16) * ascale;
#pragma unroll
        for (int ai = 0; ai < 2; ++ai)
#pragma unroll
            for (int m = 0; m < 4; ++m) { const size_t off = (size_t)(row0 + ai * HALF + m * 16) * DM + col0;
#pragma unroll
                for (int bj = 0; bj < 2; ++bj)
#pragma unroll
                    for (int n = 0; n < 2; ++n) { const f32x4 xs = *(const f32x4*)(src + off + bj * HALF + n * 16);
                        *(f32x4*)(out + off + bj * HALF + n * 16) = xs + gv[bj][n] * acc[ai][bj][m][n]; }
                if (m == 3) asm volatile("" ::: "memory"); }
    }
};
template <bool IN_F8, bool OUT_F8> struct EpiSwiGLU {
    static constexpr bool PERM = true;
    unsigned char* O; int ldc;
    __device__ __forceinline__ void operator()(const f32x4 (&acc)[2][2][4][2], const Unit& u, int wr, int wc, int fr, int fq) const {
        const int row0 = u.pm * BM + wr * 64 + fr, col0 = u.pn * HALF + wc * 32 + 8 * fq;
        constexpr float si = IN_F8 ? FP8_INV : 1.0f, so = OUT_F8 ? FP8_SA : 1.0f;
#pragma unroll
        for (int ai = 0; ai < 2; ++ai)
#pragma unroll
            for (int m = 0; m < 4; ++m) { f32x4 v0, v1;
#pragma unroll
                for (int i = 0; i < 4; ++i) { const float g0 = acc[ai][0][m][0][i] * si, g1 = acc[ai][0][m][1][i] * si;
                    v0[i] = g0 * sigmoid_f(g0) * (acc[ai][1][m][0][i] * (si * so)); v1[i] = g1 * sigmoid_f(g1) * (acc[ai][1][m][1][i] * (si * so)); }
                const size_t eo = (size_t)(row0 + ai * HALF + m * 16) * ldc + col0;
                if constexpr (OUT_F8) { u32x2 w; w.x = pk4_fp8(v0[0], v0[1], v0[2], v0[3]); w.y = pk4_fp8(v1[0], v1[1], v1[2], v1[3]); *(u32x2*)(O + eo) = w; }
                else { u32x4 w; w.x = cvt_pk_bf16(v0[0], v0[1]); w.y = cvt_pk_bf16(v0[2], v0[3]); w.z = cvt_pk_bf16(v1[0], v1[1]); w.w = cvt_pk_bf16(v1[2], v1[3]); *(u32x4*)(O + 2 * eo) = w; } }
    }
};
struct EpiPartBf16 {
    static constexpr bool PERM = true;
    bf16* Y; size_t part; float ascale;
    __device__ __forceinline__ void operator()(const f32x4 (&acc)[2][2][4][2], const Unit& u, int wr, int wc, int fr, int fq) const {
        const int ks = u.pn >> 3, pnr = u.pn & 7;
        const int row0 = u.pm * BM + wr * 64 + fr, col0 = pnr * BM + wc * 32 + 8 * fq;
        bf16* base = Y + (size_t)ks * part;
#pragma unroll
        for (int ai = 0; ai < 2; ++ai)
#pragma unroll
            for (int m = 0; m < 4; ++m) { bf16* rowp = base + (size_t)(row0 + ai * HALF + m * 16) * DM + col0;
#pragma unroll
                for (int bj = 0; bj < 2; ++bj) { const f32x4 v0 = acc[ai][bj][m][0] * ascale, v1 = acc[ai][bj][m][1] * ascale;
                    u32x4 w; w.x = cvt_pk_bf16(v0[0], v0[1]); w.y = cvt_pk_bf16(v0[2], v0[3]); w.z = cvt_pk_bf16(v1[0], v1[1]); w.w = cvt_pk_bf16(v1[2], v1[3]);
                    *(u32x4*)(rowp + bj * HALF) = w; } }
    }
};
struct EpiF32 {
    static constexpr bool PERM = false;
    float* C; int ldc; float ascale;
    __device__ __forceinline__ void operator()(const f32x4 (&acc)[2][2][4][2], const Unit& u, int wr, int wc, int fr, int fq) const {
        const int row0 = u.pm * BM + wr * 64 + fr, col0 = u.pn * BM + wc * 32 + 4 * fq;
#pragma unroll
        for (int ai = 0; ai < 2; ++ai)
#pragma unroll
            for (int m = 0; m < 4; ++m) { float* rowp = C + (size_t)(row0 + ai * HALF + m * 16) * ldc + col0;
#pragma unroll
                for (int bj = 0; bj < 2; ++bj)
#pragma unroll
                    for (int n = 0; n < 2; ++n) *(f32x4*)(rowp + bj * HALF + n * 16) = acc[ai][bj][m][n] * ascale; }
    }
};
}

namespace att {
constexpr int QBLK = 32, KVBLK = 64, LDP = INW;
constexpr float SCALE = 0.125f, THR = 8.f;
constexpr size_t SHM_V = KVBLK * 128 * 2, SHM_K = KVBLK * 128 * 2;
constexpr int LDS_WS = 2 * SHM_V + 2 * SHM_K;
#define KSWZ(row, colB) ((row) * 256 + ((colB) ^ (((row) & 7) << 4)))
#define SBAR() __builtin_amdgcn_sched_barrier(0)
__device__ __forceinline__ int crow(int r, int hi) { return (r & 3) + 8 * (r >> 2) + 4 * hi; }
__device__ __forceinline__ void partialSM(f32x16& p0, f32x16& p1, float& m_reg, float& bias, bf16x8& mB, int hi, float& alpha) {
    constexpr float THR2 = THR * 1.4426950408889634f;
    float pmax = p0[0];
#pragma unroll
    for (int r = 1; r < 16; ++r) pmax = fmaxf(pmax, p0[r]);
#pragma unroll
    for (int r = 0; r < 16; ++r) pmax = fmaxf(pmax, p1[r]);
    { auto rr = __builtin_amdgcn_permlane32_swap(__float_as_uint(pmax), __float_as_uint(pmax), false, false);
      pmax = fmaxf(__uint_as_float(rr[0]), __uint_as_float(rr[1])); }
    if (__builtin_expect(__all(pmax <= THR2 + (m_reg - bias)), 1)) { alpha = 1.f; }
    else { const unsigned mb = cvt_pk_bf16(fmaxf(m_reg, pmax + bias), 0.f) & 0xffffu; const float mn = __uint_as_float(mb << 16);
        alpha = __builtin_amdgcn_exp2f(m_reg - mn); m_reg = mn; const float dl = mn - bias; bias = mn;
        mB[0] = (short)(hi == 0 ? (mb ^ 0x8000u) : 0u);
#pragma unroll
        for (int r = 0; r < 16; ++r) { p0[r] -= dl; p1[r] -= dl; } }
#pragma unroll
    for (int r = 0; r < 16; ++r) p0[r] = __builtin_amdgcn_exp2f(p0[r]);
}
__device__ __forceinline__ void finishSM(f32x16& p0, f32x16& p1, float alpha, float& l_reg, bf16x8& pa0, bf16x8& pa1, bf16x8& pa2, bf16x8& pa3) {
#pragma unroll
    for (int r = 0; r < 16; ++r) p1[r] = __builtin_amdgcn_exp2f(p1[r]);
    float ps = 0;
#pragma unroll
    for (int r = 0; r < 16; ++r) ps += p0[r];
#pragma unroll
    for (int r = 0; r < 16; ++r) ps += p1[r];
    { auto rr = __builtin_amdgcn_permlane32_swap(__float_as_uint(ps), __float_as_uint(ps), false, false);
      ps = __uint_as_float(rr[0]) + __uint_as_float(rr[1]); }
    l_reg = l_reg * alpha + ps;
#define PK4(P, BASE, OUT) do { unsigned a0 = cvt_pk_bf16(P[BASE + 0], P[BASE + 1]), a1 = cvt_pk_bf16(P[BASE + 2], P[BASE + 3]);   \
    unsigned b0 = cvt_pk_bf16(P[BASE + 4], P[BASE + 5]), b1 = cvt_pk_bf16(P[BASE + 6], P[BASE + 7]);                              \
    auto r0 = __builtin_amdgcn_permlane32_swap(a0, b0, false, false); auto r1 = __builtin_amdgcn_permlane32_swap(a1, b1, false, false); \
    u32x4 w = {r0[0], r1[0], r0[1], r1[1]}; OUT = *reinterpret_cast<bf16x8*>(&w); } while (0)
    PK4(p0, 0, pa0); PK4(p0, 8, pa1); PK4(p1, 0, pa2); PK4(p1, 8, pa3);
#undef PK4
}
__device__ __forceinline__ void qkt(f32x16& p0, f32x16& p1, const char* Ks, const bf16x8* qr, int r32, int hi, int pair, bf16x8 oneA, bf16x8 mB) {
    p0 = __builtin_amdgcn_mfma_f32_32x32x16_bf16(oneA, mB, f32x16{}, 0, 0, 0); p1 = __builtin_amdgcn_mfma_f32_32x32x16_bf16(oneA, mB, f32x16{}, 0, 0, 0);
#pragma unroll
    for (int d0 = 0; d0 < 4; ++d0) { const int cb = (pair * 64 + d0 * 16 + hi * 8) * 2;
        const bf16x8 b0 = *reinterpret_cast<const bf16x8*>(Ks + KSWZ(r32, cb));
        const bf16x8 b1 = *reinterpret_cast<const bf16x8*>(Ks + KSWZ(32 + r32, cb));
        p0 = __builtin_amdgcn_mfma_f32_32x32x16_bf16(b0, qr[d0], p0, 0, 0, 0);
        p1 = __builtin_amdgcn_mfma_f32_32x32x16_bf16(b1, qr[d0], p1, 0, 0, 0); }
}
__device__ __forceinline__ int v_st(int k, int c) { const int kk = (k & ~0xC) | ((k & 4) << 1) | ((k & 8) >> 1); return ((kk >> 3) * 4 + (c >> 5)) * 512 + ((kk & 7) * 32 + (c & 31)) * 2; }
__device__ __forceinline__ int v_rd_base(int lane) { return ((lane & 3) << 3) | (((lane >> 2) & 3) << 6) | (((lane >> 4) & 1) << 5) | (((lane >> 5) & 1) << 8); }
constexpr int v_rd_off(int d0, int ks, int half) { return d0 * 512 + ks * 4096 + half * 2048; }
template <int OFF> __device__ __forceinline__ s16x4 tr_read(int vb) {
    s16x4 r; asm volatile("ds_read_b64_tr_b16 %0, %1 offset:%2" : "=&v"(r) : "v"(vb), "i"(OFF) : "memory"); return r;
}
template <int D0> __device__ __forceinline__ void pv_one(f32x16& od, int vb, bf16x8 pa0, bf16x8 pa1, bf16x8 pa2, bf16x8 pa3) {
    const s16x4 l0 = tr_read<v_rd_off(D0, 0, 0)>(vb), h0 = tr_read<v_rd_off(D0, 0, 1)>(vb), l1 = tr_read<v_rd_off(D0, 1, 0)>(vb), h1 = tr_read<v_rd_off(D0, 1, 1)>(vb);
    const s16x4 l2 = tr_read<v_rd_off(D0, 2, 0)>(vb), h2 = tr_read<v_rd_off(D0, 2, 1)>(vb), l3 = tr_read<v_rd_off(D0, 3, 0)>(vb), h3 = tr_read<v_rd_off(D0, 3, 1)>(vb);
    asm volatile("s_waitcnt lgkmcnt(0)" ::: "memory"); SBAR();
#define PK(L, H) (bf16x8){L[0], L[1], L[2], L[3], H[0], H[1], H[2], H[3]}
    od = __builtin_amdgcn_mfma_f32_32x32x16_bf16(pa0, PK(l0, h0), od, 0, 0, 0);
    od = __builtin_amdgcn_mfma_f32_32x32x16_bf16(pa1, PK(l1, h1), od, 0, 0, 0);
    od = __builtin_amdgcn_mfma_f32_32x32x16_bf16(pa2, PK(l2, h2), od, 0, 0, 0);
    od = __builtin_amdgcn_mfma_f32_32x32x16_bf16(pa3, PK(l3, h3), od, 0, 0, 0);
#undef PK
}
__device__ __forceinline__ void pv_d0(f32x16* o, int vb, bf16x8 pa0, bf16x8 pa1, bf16x8 pa2, bf16x8 pa3) {
    pv_one<0>(o[0], vb, pa0, pa1, pa2, pa3); pv_one<1>(o[1], vb, pa0, pa1, pa2, pa3); pv_one<2>(o[2], vb, pa0, pa1, pa2, pa3); pv_one<3>(o[3], vb, pa0, pa1, pa2, pa3);
}
__device__ __forceinline__ void diff_attn_unit(const bf16* __restrict__ Qb, const bf16* __restrict__ K0, int nt0, const bf16* __restrict__ K1, int nt1,
                                               bf16* __restrict__ Ob, int ldo, float lam, const float* __restrict__ subg, float gmul, char* lds) {
    int tid = threadIdx.x; asm volatile("" : "+v"(tid));
    const int wid = __builtin_amdgcn_readfirstlane(tid >> 6), lane = tid & 63, r32 = lane & 31, hi = lane >> 5;
    const int pair = wid >> 2, wq = wid & 3;
    char* V_lds = lds; char* K_lds = lds + 2 * SHM_V;
    float* ws = (float*)(lds + LDS_WS) + wid * 64; float* li_l = ws; float* al_l = ws + 32;
    float m_reg = -1e30f, l_reg = 0; f32x16 o[4] = {}; bf16x8 qr[4];
    const bf16* Qw = Qb + (long)(wq * QBLK + r32) * LDP + pair * 64 + hi * 8;
#pragma unroll
    for (int d0 = 0; d0 < 4; ++d0) qr[d0] = *reinterpret_cast<const bf16x8*>(Qw + d0 * 16);
    const int sr = tid >> 4, sc = (tid & 15) * 8, vst0 = v_st(sr, sc), vst1 = v_st(32 + sr, sc);
    const int vb0 = (int)(uintptr_t)V_lds + v_rd_base(lane);
    struct { bf16x8 vs0, vs1, ks0, ks1; } sr_[2];
#define KT(t) (((t) < nt0) ? (K0 + (long)(t) * KVBLK * LDP) : (K1 + (long)((t) - nt0) * KVBLK * LDP))
#define SLOAD(i, t) do { const bf16* kt_ = KT(t); sr_[i].vs0 = *reinterpret_cast<const bf16x8*>(&kt_[(long)sr * LDP + 1024 + sc]); sr_[i].vs1 = *reinterpret_cast<const bf16x8*>(&kt_[(long)(32 + sr) * LDP + 1024 + sc]); \
    sr_[i].ks0 = *reinterpret_cast<const bf16x8*>(&kt_[(long)sr * LDP + sc]); sr_[i].ks1 = *reinterpret_cast<const bf16x8*>(&kt_[(long)(32 + sr) * LDP + sc]); } while (0)
#define SWRITE(b, i) do { *(bf16x8*)(V_lds + (b) * SHM_V + vst0) = sr_[i].vs0; *(bf16x8*)(V_lds + (b) * SHM_V + vst1) = sr_[i].vs1; const int kc = sc * 2; \
    *(bf16x8*)(K_lds + (b) * SHM_K + KSWZ(sr, kc)) = sr_[i].ks0; *(bf16x8*)(K_lds + (b) * SHM_K + KSWZ(32 + sr, kc)) = sr_[i].ks1; } while (0)
#define SWAIT() asm volatile("s_waitcnt vmcnt(4)" ::: "memory")
#define RESC(a) do { if (__any((a) < 1.f)) { if (hi == 0) al_l[r32] = (a); asm volatile("s_waitcnt lgkmcnt(0)" ::: "memory"); \
    _Pragma("unroll") for (int d = 0; d < 4; ++d) _Pragma("unroll") for (int r = 0; r < 16; ++r) o[d][r] *= al_l[crow(r, hi)]; } } while (0)
    f32x16 pA0, pA1, pB0, pB1; float alA, alB, bias = 0.f; bf16x8 mB = {}; bf16x8 oneA = {}; oneA[0] = (short)(hi == 0 ? 0x3f80 : 0); bf16x8 pa0, pa1, pa2, pa3; const int NT = nt0 + nt1;
    constexpr int SE = 0, SO = 1;
    SLOAD(SE, 0); asm volatile("s_waitcnt vmcnt(0)" ::: "memory"); SWRITE(0, SE); __syncthreads();
    qkt(pA0, pA1, K_lds, qr, r32, hi, pair, oneA, mB); partialSM(pA0, pA1, m_reg, bias, mB, hi, alA);
    SLOAD(SO, 1); if (2 < NT) SLOAD(SE, 2);
    SWAIT(); SWRITE(1, SO); __syncthreads();
    for (int j = 1; j + 1 < NT; j += 2) {
        SBAR(); qkt(pB0, pB1, K_lds + SHM_K, qr, r32, hi, pair, oneA, mB);
        finishSM(pA0, pA1, alA, l_reg, pa0, pa1, pa2, pa3); SBAR();
        SLOAD(SO, (j + 2 < NT) ? (j + 2) : (NT - 1)); SBAR();
        pv_d0(o, vb0, pa0, pa1, pa2, pa3); partialSM(pB0, pB1, m_reg, bias, mB, hi, alB);
        __syncthreads(); SWAIT(); SWRITE(0, SE);
        RESC(alB); __syncthreads();
        SBAR(); qkt(pA0, pA1, K_lds, qr, r32, hi, pair, oneA, mB);
        finishSM(pB0, pB1, alB, l_reg, pa0, pa1, pa2, pa3); SBAR();
        if (j + 3 < NT) SLOAD(SE, j + 3); SBAR();
        pv_d0(o, vb0 + (int)SHM_V, pa0, pa1, pa2, pa3); partialSM(pA0, pA1, m_reg, bias, mB, hi, alA);
        __syncthreads(); SWAIT(); SWRITE(1, SO);
        RESC(alA); __syncthreads();
    }
    SBAR(); qkt(pB0, pB1, K_lds + SHM_K, qr, r32, hi, pair, oneA, mB);
    finishSM(pA0, pA1, alA, l_reg, pa0, pa1, pa2, pa3); SBAR();
    pv_d0(o, vb0, pa0, pa1, pa2, pa3); partialSM(pB0, pB1, m_reg, bias, mB, hi, alB);
    __syncthreads(); RESC(alB);
    finishSM(pB0, pB1, alB, l_reg, pa0, pa1, pa2, pa3); SBAR();
    pv_d0(o, vb0 + (int)SHM_V, pa0, pa1, pa2, pa3);
    if (hi == 0) li_l[r32] = l_reg; asm volatile("s_waitcnt lgkmcnt(0)" ::: "memory");
    float rli[16];
#pragma unroll
    for (int r = 0; r < 16; ++r) rli[r] = __builtin_amdgcn_rcpf(li_l[crow(r, hi)]);
    asm volatile("s_waitcnt vmcnt(0)" ::: "memory");
    __syncthreads();
    float* X = (float*)lds + wq * (QBLK * 128);
    if (pair == 1) {
#pragma unroll
        for (int r = 0; r < 16; ++r) { const float s = rli[r] * lam;
#pragma unroll
            for (int d0 = 0; d0 < 4; ++d0) X[crow(r, hi) * 128 + d0 * 32 + r32] = o[d0][r] * s; }
    }
    __syncthreads();
    if (pair == 0) {
        float gsub[4];
#pragma unroll
        for (int d0 = 0; d0 < 4; ++d0) gsub[d0] = subg[d0 * 32 + r32] * gmul;
#pragma unroll
        for (int r = 0; r < 16; ++r) { float ss = 0.f;
#pragma unroll
            for (int d0 = 0; d0 < 4; ++d0) { const float v = o[d0][r] * rli[r] - X[crow(r, hi) * 128 + d0 * 32 + r32]; o[d0][r] = v; ss += v * v; }
            ss = row16_sum(ss); ss += __shfl_xor(ss, 16);
            const float rstd = 1.0f / sqrtf(ss * (1.0f / 128.0f) + EPS);
            bf16* orow = Ob + (long)(wq * QBLK + crow(r, hi)) * ldo;
#pragma unroll
            for (int d0 = 0; d0 < 4; ++d0) orow[d0 * 32 + r32] = (bf16)(cvt_pk_bf16(o[d0][r] * rstd * gsub[d0], 0.f) & 0xffffu); }
    }
    __syncthreads();
#undef KT
#undef SLOAD
#undef SWRITE
#undef SWAIT
#undef RESC
}
#undef KSWZ
#undef SBAR
}

#define XB_TMO      128
#define XB_XCNT(j)  (256  + 64 * (j))
#define XB_XSUB(j)  (1280 + 64 * (j))
#define XB_XGEN(j)  (2304 + 64 * (j))
#define XB_TOP      3328
#define XB_TOPGEN   3392
#define XCD_BAR_WORDS 3456
#define XB_SPIN_CAP (1u << 18)
__device__ __forceinline__ unsigned xb_ld(unsigned* p)              { return __hip_atomic_load(p, __ATOMIC_RELAXED, __HIP_MEMORY_SCOPE_AGENT); }
__device__ __forceinline__ unsigned xb_add(unsigned* p, unsigned v) { return __hip_atomic_fetch_add(p, v, __ATOMIC_RELAXED, __HIP_MEMORY_SCOPE_AGENT); }
__device__ __forceinline__ unsigned xb_xcc_id() { return (unsigned)__builtin_amdgcn_s_getreg((3 << 11) | 20) & 0xFu; }
#define XB_SPIN(cond, bar) do { unsigned _sp = 0; while (cond) { __builtin_amdgcn_s_sleep(1); \
    if ((++_sp & 255u) == 0u) { if (xb_ld(&(bar)[XB_TMO])) break; if (_sp > XB_SPIN_CAP) { atomicAdd(&(bar)[XB_TMO], 1u); break; } } } } while (0)
struct XcdBarrier { unsigned* bar; unsigned x; volatile LAS unsigned* st; };
__device__ __forceinline__ XcdBarrier xcd_barrier_post(unsigned* bar, volatile LAS unsigned* st) {
    XcdBarrier b; b.bar = bar; b.x = xb_xcc_id(); b.st = st;
    if (threadIdx.x == 0) (void)xb_add(&bar[XB_XCNT(b.x)], 1u);
    return b;
}
__device__ __forceinline__ void xcd_barrier_complete(unsigned* bar, unsigned x, unsigned& nloc, unsigned& nx) {
    const unsigned G = gridDim.x * gridDim.y * gridDim.z;
    unsigned sum, cnt, mine, sp = 0u;
    for (;;) {
        sum = 0u; cnt = 0u; mine = 0u;
#pragma unroll
        for (unsigned j = 0; j < 16; ++j) { const unsigned c = xb_ld(&bar[XB_XCNT(j)]); sum += c; cnt += (c > 0u) ? 1u : 0u; mine = (j == x) ? c : mine; }
        if (sum == G) break;
        __builtin_amdgcn_s_sleep(1);
        if ((++sp & 255u) == 0u) { if (xb_ld(&bar[XB_TMO])) break; if (sp > XB_SPIN_CAP) { atomicAdd(&bar[XB_TMO], 1u); break; } }
    }
    nloc = mine > 0u ? mine : 1u; nx = cnt > 0u ? cnt : 1u;
}
__device__ __forceinline__ void xcd_barrier(const XcdBarrier& b) {
    asm volatile("s_waitcnt vmcnt(0)" ::: "memory");
    __syncthreads();
    if (threadIdx.x == 0) {
        unsigned* bar = b.bar;
        __builtin_amdgcn_s_waitcnt(0);
        unsigned nloc = b.st[0], nx = b.st[1];
        if (nloc == 0u) { xcd_barrier_complete(bar, b.x, nloc, nx); b.st[0] = nloc; b.st[1] = nx; }
        const unsigned old = xb_add(&bar[XB_XSUB(b.x)], 1u);
        const unsigned gen = old / nloc;
        if (old + 1u == (gen + 1u) * nloc) {
            __builtin_amdgcn_fence(__ATOMIC_RELEASE, "agent");
            asm volatile("s_waitcnt vmcnt(0)" ::: "memory");
            const unsigned og = xb_add(&bar[XB_TOP], 1u);
            const unsigned tg = og / nx;
            if (og + 1u == (tg + 1u) * nx) xb_add(&bar[XB_TOPGEN], 1u);
            else XB_SPIN(xb_ld(&bar[XB_TOPGEN]) == tg, bar);
            __builtin_amdgcn_fence(__ATOMIC_ACQUIRE, "agent");
            xb_add(&bar[XB_XGEN(b.x)], 1u);
            asm volatile("s_waitcnt vmcnt(0)" ::: "memory");
        } else {
            XB_SPIN(xb_ld(&bar[XB_XGEN(b.x)]) == gen, bar);
            __builtin_amdgcn_fence(__ATOMIC_ACQUIRE, "agent");
            asm volatile("s_waitcnt vmcnt(0)" ::: "memory");
        }
    }
    __syncthreads();
}

struct Args { const float* in[31]; float* out; unsigned char* ws; int ph_lo, ph_hi; };
enum { I_X = 0, I_C, I_CTX, I_CCTX, I_WMOD, I_BMOD, I_N1G, I_N2G, I_WIN, I_POOLW, I_POOLS, I_SGUNG, I_SGUW, I_SGUB, I_LQ1, I_LK1, I_LQ2, I_LK2, I_SUBG,
       I_WPA, I_WPB, I_WPC, I_WO, I_FW1, I_FW3, I_FW2, I_ROUTER, I_MW1, I_MW3, I_MW2, I_FNG };

struct Frame {
    LAS unsigned char* lds; unsigned char* ws; const Args* a;
    int tid, lane, wave, vcu, G;
};

__device__ __forceinline__ void frame_refresh(Frame& F) {
    int tid = threadIdx.x; asm volatile("" : "+v"(tid));
    F.tid = tid; F.lane = tid & 63; F.wave = __builtin_amdgcn_readfirstlane(tid >> 6);
}
struct TDesc { const float* src; bf16* dst; int K, N, batch; long sstride, dstride; long dpitch; int koff, mode, f8; unsigned char* dst8; int split; };
__device__ __forceinline__ void get_tdesc(int d, const Args& a, unsigned char* ws, TDesc& t) {
    t.batch = 1; t.sstride = 0; t.dstride = 0; t.koff = 0; t.mode = 0; t.f8 = 0; t.dst8 = nullptr; t.split = 1 << 30;
    switch (d) {
    case 0: t.src = a.in[I_WIN]; t.dst = (bf16*)(ws + WS_WIN); t.K = DM; t.N = INW; t.batch = 2; t.sstride = (long)DM * INW; t.dstride = (long)INW * DM; t.dpitch = DM; t.dst8 = ws + WS_WIN8; t.split = F8_GATES ? IN_SPLIT : (1 << 30); break;
    case 1: t.src = a.in[I_WPA]; t.dst = (bf16*)(ws + WS_WPC); t.K = 1024; t.N = DM; t.batch = 2; t.sstride = 1024L * DM; t.dstride = 2048L * 3072; t.dpitch = 3072; t.koff = 0; break;
    case 2: t.src = a.in[I_WPB]; t.dst = (bf16*)(ws + WS_WPC); t.K = 1024; t.N = DM; t.batch = 2; t.sstride = 1024L * DM; t.dstride = 2048L * 3072; t.dpitch = 3072; t.koff = 1024; break;
    case 3: t.src = a.in[I_WPC]; t.dst = (bf16*)(ws + WS_WPC); t.K = 1024; t.N = DM; t.batch = 2; t.sstride = 1024L * DM; t.dstride = 2048L * 3072; t.dpitch = 3072; t.koff = 2048; break;
    case 4: t.src = a.in[I_WO]; t.dst = (bf16*)(ws + WS_WO); t.K = DM; t.N = DM; t.batch = 2; t.sstride = (long)DM * DM; t.dstride = (long)DM * DM; t.dpitch = DM; break;
    case 5: t.src = a.in[I_POOLW]; t.dst = (bf16*)(ws + WS_WPOOL); t.K = 256; t.N = 256; t.batch = 8; t.sstride = 65536; t.dstride = 65536; t.dpitch = 256; break;
    case 6: t.src = a.in[I_FW1]; t.dst = (bf16*)(ws + WS_W13); t.K = DM; t.N = DFF; t.dpitch = DM; t.mode = 1; t.f8 = F8_FFN1; break;
    case 7: t.src = a.in[I_FW3]; t.dst = (bf16*)(ws + WS_W13); t.K = DM; t.N = DFF; t.dpitch = DM; t.mode = 2; t.f8 = F8_FFN1; break;
    case 8: t.src = a.in[I_FW2]; t.dst = (bf16*)(ws + WS_W2); t.K = DFF; t.N = DM; t.dpitch = DFF; t.f8 = F8_FFN2; break;
    case 9: t.src = a.in[I_MW1]; t.dst = (bf16*)(ws + WS_MW13); t.K = DM; t.N = DFE; t.batch = NE; t.sstride = (long)DM * DFE; t.dstride = 2L * DFE * DM; t.dpitch = DM; t.mode = 1; t.f8 = F8_MOE1; break;
    case 10: t.src = a.in[I_MW3]; t.dst = (bf16*)(ws + WS_MW13); t.K = DM; t.N = DFE; t.batch = NE; t.sstride = (long)DM * DFE; t.dstride = 2L * DFE * DM; t.dpitch = DM; t.mode = 2; t.f8 = F8_MOE1; break;
    default: t.src = a.in[I_MW2]; t.dst = (bf16*)(ws + WS_MW2); t.K = DFE; t.N = DM; t.batch = NE; t.sstride = (long)DFE * DM; t.dstride = (long)DM * DFE; t.dpitch = DFE; t.f8 = F8_MOE2; break;
    }
}
constexpr int N_TDESC = 12;
__host__ __device__ constexpr long tdesc_items(int d) {
    return d == 0 ? 2L * 32 * 192 : (d >= 1 && d <= 3) ? 2L * 16 * 32 : d == 4 ? 2L * 32 * 32 : d == 5 ? 8L * 4 * 4 : (d == 6 || d == 7) ? 32L * 88 : d == 8 ? 88L * 32 : (d == 9 || d == 10) ? 8L * 32 * 112 : 8L * 112 * 32;
}
__device__ __forceinline__ void tr_item(const TDesc& t, long item, LAS float* scr, int lane) {
    const int nK = t.K / 64, nN = t.N / 64;
    int nb, kb, bt;
    if ((nK & 7) == 0) { const int k8 = (int)(item & 7); const long r0 = item >> 3; nb = (int)(r0 % nN); const long r1 = r0 / nN; const int kq = (int)(r1 % (nK >> 3)); bt = (int)(r1 / (nK >> 3)); kb = kq * 8 + k8; }
    else { nb = (int)(item % nN); const long r1 = item / nN; kb = (int)(r1 % nK); bt = (int)(r1 / nK); }
    const float* W = t.src + (long)bt * t.sstride; bf16* WT = t.dst + (t.f8 ? 0 : (long)bt * t.dstride); unsigned char* WT8 = (unsigned char*)t.dst + (long)bt * t.dstride;
    const int k0 = kb * 64, n0 = nb * 64;
    f32x4 v[16];
#pragma unroll
    for (int i = 0; i < 16; ++i) v[i] = __builtin_nontemporal_load((const f32x4*)(W + (size_t)(k0 + 4 * i + (lane >> 4)) * t.N + n0 + (lane & 15) * 4));
#pragma unroll
    for (int i = 0; i < 16; ++i) { LAS float* d = scr + (4 * i + (lane >> 4)) * 65 + (lane & 15) * 4; d[0] = v[i][0]; d[1] = v[i][1]; d[2] = v[i][2]; d[3] = v[i][3]; }
    LDS_WAIT();
    const int c = lane & 7;
#pragma unroll
    for (int j = 0; j < 8; ++j) { const int n = (lane >> 3) + 8 * j; const LAS float* s = scr + (8 * c) * 65 + n;
        u32x4 o; o.x = cvt_pk_bf16(s[0 * 65], s[1 * 65]); o.y = cvt_pk_bf16(s[2 * 65], s[3 * 65]); o.z = cvt_pk_bf16(s[4 * 65], s[5 * 65]); o.w = cvt_pk_bf16(s[6 * 65], s[7 * 65]);
        const int ng = n0 + n; const long drow = t.mode == 0 ? (long)ng : ((long)(ng >> 7) * 256 + (t.mode == 2 ? 128 : 0) + (ng & 127));
        if (ng >= t.split) { u32x2 o8; o8.x = pk4_fp8(s[0 * 65] * FP8_SW, s[1 * 65] * FP8_SW, s[2 * 65] * FP8_SW, s[3 * 65] * FP8_SW); o8.y = pk4_fp8(s[4 * 65] * FP8_SW, s[5 * 65] * FP8_SW, s[6 * 65] * FP8_SW, s[7 * 65] * FP8_SW);
            *(u32x2*)(t.dst8 + ((long)bt * (t.N - t.split) + (ng - t.split)) * t.K + k0 + 8 * c) = o8; }
        else if (t.f8) { u32x2 o8; o8.x = pk4_fp8(s[0 * 65] * FP8_SW, s[1 * 65] * FP8_SW, s[2 * 65] * FP8_SW, s[3 * 65] * FP8_SW); o8.y = pk4_fp8(s[4 * 65] * FP8_SW, s[5 * 65] * FP8_SW, s[6 * 65] * FP8_SW, s[7 * 65] * FP8_SW);
            *(u32x2*)(WT8 + drow * t.dpitch + t.koff + k0 + 8 * c) = o8; }
        else *(u32x4*)(WT + drow * t.dpitch + t.koff + k0 + 8 * c) = o; }
    LDS_WAIT();
}

__device__ __forceinline__ void mod_sil(Frame& F) {
    LAS float* sil = (LAS float*)F.lds; const float* cv = F.a->in[I_C]; const float* cc = F.a->in[I_CCTX];
    for (int idx = F.tid; idx < 5 * DM; idx += 512) { const int j = idx / DM, k = idx % DM; const float c = (j < 4) ? cv[j * DM + k] : cc[k]; sil[idx] = c / (1.0f + __expf(-c)); }
    __syncthreads();
}
__device__ __forceinline__ void mod_unit(Frame& F, int unit) {
    const int l = unit / 384, cb = unit % 384;
    LAS float* sil = (LAS float*)F.lds; LAS float* red = (LAS float*)(F.lds + 40960);
    const int q = F.lane & 7, kg = F.lane >> 3, col0 = cb * 32 + 4 * q, kbase = F.wave * 256 + kg * 32;
    const float* wm = F.a->in[I_WMOD] + ((size_t)l * DM + kbase) * (6 * DM) + col0;
    f32x4 acc[5];
#pragma unroll
    for (int j = 0; j < 5; ++j) acc[j] = (f32x4){0.f, 0.f, 0.f, 0.f};
#pragma unroll 8
    for (int kk = 0; kk < 32; ++kk) { const f32x4 wv = __builtin_nontemporal_load((const f32x4*)(wm + (size_t)kk * (6 * DM)));
#pragma unroll
        for (int j = 0; j < 5; ++j) acc[j] += sil[j * DM + kbase + kk] * wv; }
#pragma unroll
    for (int o = 8; o < 64; o <<= 1)
#pragma unroll
        for (int j = 0; j < 5; ++j)
#pragma unroll
            for (int e = 0; e < 4; ++e) acc[j][e] += __shfl_xor(acc[j][e], o);
    if (kg == 0) {
#pragma unroll
        for (int j = 0; j < 5; ++j) *(LAS f32x4*)(red + (F.wave * 5 + j) * 32 + 4 * q) = acc[j]; }
    __syncthreads();
    float* MOD = (float*)(F.ws + WS_MOD);
    if (F.tid < 5 * 32) { const int j = F.tid / 32, cidx = F.tid % 32; float sum = 0.f;
#pragma unroll
        for (int w = 0; w < 8; ++w) sum += red[(w * 5 + j) * 32 + cidx];
        MOD[((size_t)l * 5 + j) * (6 * DM) + cb * 32 + cidx] = sum + F.a->in[I_BMOD][(size_t)l * (6 * DM) + cb * 32 + cidx]; }
    __syncthreads();
}

template <bool F8OUT = false, bool BOTH = false>
__device__ __forceinline__ void normmod_row(const float* xrow, const float* g, const float* sh, const float* sc, bf16* orow, int lane_, f32x4 (&hv)[8], unsigned char* orow8 = nullptr) {
    int lane = lane_;
    asm volatile("" : "+v"(lane));
    f32x4 v[8]; float ss = 0.f;
#pragma unroll
    for (int j = 0; j < 8; ++j) { v[j] = ((const f32x4*)xrow)[lane + 64 * j]; ss += (v[j][0] * v[j][0] + v[j][1] * v[j][1]) + (v[j][2] * v[j][2] + v[j][3] * v[j][3]); }
    const float rstd = 1.0f / sqrtf(wave_sum(ss) * (1.0f / DM) + EPS);
#pragma unroll
    for (int j = 0; j < 8; ++j) { const int c4 = lane + 64 * j; const f32x4 gg = ((const f32x4*)g)[c4], s1 = ((const f32x4*)sh)[c4], s2 = ((const f32x4*)sc)[c4];
        const f32x4 h = (v[j] * rstd * gg) * (1.0f + s2) + s1; hv[j] = h;
        if constexpr (F8OUT) ((unsigned*)orow)[c4] = pk4_fp8(h[0] * FP8_SA, h[1] * FP8_SA, h[2] * FP8_SA, h[3] * FP8_SA);
        else { u32x2 w; w.x = cvt_pk_bf16(h[0], h[1]); w.y = cvt_pk_bf16(h[2], h[3]); ((u32x2*)orow)[c4] = w; }
        if constexpr (BOTH) ((unsigned*)orow8)[c4] = pk4_fp8(h[0] * FP8_SA, h[1] * FP8_SA, h[2] * FP8_SA, h[3] * FP8_SA);
        if ((j & 3) == 3) asm volatile("" ::: "memory"); }
}

__device__ __forceinline__ float dot2_bf16(unsigned a, unsigned b, float c) {
    typedef __bf16 bf2_t __attribute__((ext_vector_type(2)));
    return __builtin_amdgcn_fdot2_f32_bf16(__builtin_bit_cast(bf2_t, a), __builtin_bit_cast(bf2_t, b), c, false);
}
__device__ __forceinline__ void sgu_unit(Frame& F, int L, int chunk, int g) {
    constexpr int PITCH = 136;
    LAS bf16* Wb = (LAS bf16*)F.lds; LAS bf16* VT = (LAS bf16*)(F.lds + 128 * PITCH * 2); LAS float* stats = (LAS float*)(F.lds + 2 * 128 * PITCH * 2);
    const bf16* P = (const bf16*)(F.ws + WS_P); bf16* CAT = (bf16*)(F.ws + WS_CAT);
    const int r0 = chunk * 128, tid = F.tid, lane = F.lane, wave = F.wave;
    const float* Wsrc = F.a->in[I_SGUW] + ((size_t)L * 8 + g) * 16384;
    f32x4 wreg[8];
#pragma unroll
    for (int i = 0; i < 8; ++i) wreg[i] = *(const f32x4*)(Wsrc + (size_t)(tid + 512 * i) * 4);
    const bf16* vp2 = P + (size_t)(r0 + 2 * lane) * INW + OFF_B + 1024 + g * 128 + wave * 16;
    const u32x4 v00 = *(const u32x4*)vp2, v01 = *(const u32x4*)(vp2 + 8), v10 = *(const u32x4*)(vp2 + INW), v11 = *(const u32x4*)(vp2 + INW + 8);
    {
        u32x4 a[16], b[16];
#pragma unroll
        for (int rr = 0; rr < 16; ++rr) { const bf16* vp = P + (size_t)(r0 + wave * 16 + rr) * INW + OFF_B + 1024; a[rr] = *(const u32x4*)(vp + lane * 8); b[rr] = *(const u32x4*)(vp + 512 + lane * 8); }
#pragma unroll
        for (int rr = 0; rr < 16; ++rr) {
            constexpr unsigned ONE2 = 0x3f803f80u;
            float sx = 0.f, sq = 0.f;
            sx = dot2_bf16(a[rr].x, ONE2, sx); sx = dot2_bf16(a[rr].y, ONE2, sx); sx = dot2_bf16(a[rr].z, ONE2, sx); sx = dot2_bf16(a[rr].w, ONE2, sx);
            sx = dot2_bf16(b[rr].x, ONE2, sx); sx = dot2_bf16(b[rr].y, ONE2, sx); sx = dot2_bf16(b[rr].z, ONE2, sx); sx = dot2_bf16(b[rr].w, ONE2, sx);
            sq = dot2_bf16(a[rr].x, a[rr].x, sq); sq = dot2_bf16(a[rr].y, a[rr].y, sq); sq = dot2_bf16(a[rr].z, a[rr].z, sq); sq = dot2_bf16(a[rr].w, a[rr].w, sq);
            sq = dot2_bf16(b[rr].x, b[rr].x, sq); sq = dot2_bf16(b[rr].y, b[rr].y, sq); sq = dot2_bf16(b[rr].z, b[rr].z, sq); sq = dot2_bf16(b[rr].w, b[rr].w, sq);
            const float mu = wave_sum(sx) * (1.0f / 1024.0f);
            const float var = fmaxf(wave_sum(sq) * (1.0f / 1024.0f) - mu * mu, 0.f);
            const float rstd = 1.0f / sqrtf(var + EPS);
            const int row = wave * 16 + rr;
            if (lane == 0) { stats[2 * row] = mu; stats[2 * row + 1] = rstd; } } }
#pragma unroll
    for (int i = 0; i < 8; ++i) { const int i4 = tid + 512 * i; const f32x4 w = wreg[i]; const int p = i4 >> 5, q = (i4 & 31) * 4;
        u32x2 o; o.x = cvt_pk_bf16(w[0], w[1]); o.y = cvt_pk_bf16(w[2], w[3]); *(LAS u32x2*)(Wb + p * PITCH + q) = o; }
    __syncthreads();
    { const f32x4 st = *(const LAS f32x4*)(stats + 4 * lane);
      const float* ng = F.a->in[I_SGUNG] + (size_t)L * 1024 + g * 128 + wave * 16;
      LAS unsigned* VT32 = (LAS unsigned*)VT;
      const unsigned x0[8] = {v00.x, v00.y, v00.z, v00.w, v01.x, v01.y, v01.z, v01.w}, x1[8] = {v10.x, v10.y, v10.z, v10.w, v11.x, v11.y, v11.z, v11.w};
#pragma unroll
      for (int e = 0; e < 8; ++e) {
          const float g0 = ng[2 * e], g1 = ng[2 * e + 1];
          VT32[(wave * 16 + 2 * e) * (PITCH / 2) + lane]     = cvt_pk_bf16((bf_lo(x0[e]) - st[0]) * st[1] * g0, (bf_lo(x1[e]) - st[2]) * st[3] * g0);
          VT32[(wave * 16 + 2 * e + 1) * (PITCH / 2) + lane] = cvt_pk_bf16((bf_hi(x0[e]) - st[0]) * st[1] * g1, (bf_hi(x1[e]) - st[2]) * st[3] * g1); } }
    __syncthreads();
    const int fr = lane & 15, fq = lane >> 4;
    f32x4 acc[8];
#pragma unroll
    for (int nb = 0; nb < 8; ++nb) acc[nb] = (f32x4){0.f, 0.f, 0.f, 0.f};
#pragma unroll
    for (int k0 = 0; k0 < 4; ++k0) { const bf16x8 af = *(const LAS bf16x8*)(Wb + (wave * 16 + fr) * PITCH + k0 * 32 + fq * 8);
#pragma unroll
        for (int nb = 0; nb < 8; ++nb) { const bf16x8 bf = *(const LAS bf16x8*)(VT + (nb * 16 + fr) * PITCH + k0 * 32 + fq * 8);
            acc[nb] = __builtin_amdgcn_mfma_f32_16x16x32_bf16(bf, af, acc[nb], 0, 0, 0); } }
    { const int p = wave * 16 + fr; const float bias = F.a->in[I_SGUB][((size_t)L * 8 + g) * 128 + p];
      const bf16* up = P + (size_t)(r0 + p) * INW + OFF_B + g * 128; bf16* op = CAT + (size_t)(r0 + p) * 3072 + 1024 + g * 128;
#pragma unroll
      for (int nb = 0; nb < 8; ++nb) { const int c = nb * 16 + 4 * fq; const u32x2 uu = *(const u32x2*)(up + c);
          u32x2 o; o.x = cvt_pk_bf16((acc[nb][0] + bias) * bf_lo(uu.x), (acc[nb][1] + bias) * bf_hi(uu.x)); o.y = cvt_pk_bf16((acc[nb][2] + bias) * bf_lo(uu.y), (acc[nb][3] + bias) * bf_hi(uu.y));
          *(u32x2*)(op + c) = o; } }
    __syncthreads();
}

template <int HW> __device__ __forceinline__ void pool_block(const bf16* P, bf16* PO, int sb, int slen, int s0, int c) {
    constexpr int NR = 16 + 2 * HW - 1;
    u32x4 r[NR];
#pragma unroll
    for (int k = 0; k < NR; ++k) { const int pos = s0 - HW + k; r[k] = (u32x4){0u, 0u, 0u, 0u}; if (pos >= 0 && pos < slen) r[k] = *(const u32x4*)(P + (size_t)(sb + pos) * INW + c); }
    float sum[8] = {0.f, 0.f, 0.f, 0.f, 0.f, 0.f, 0.f, 0.f};
#define POOL_ACC(SGN, R) do { sum[0] += SGN bf_lo(R.x); sum[1] += SGN bf_hi(R.x); sum[2] += SGN bf_lo(R.y); sum[3] += SGN bf_hi(R.y); sum[4] += SGN bf_lo(R.z); sum[5] += SGN bf_hi(R.z); sum[6] += SGN bf_lo(R.w); sum[7] += SGN bf_hi(R.w); } while (0)
#pragma unroll
    for (int k = 0; k < 2 * HW - 1; ++k) POOL_ACC(+, r[k]);
#pragma unroll
    for (int i = 0; i < 16; ++i) { POOL_ACC(+, r[i + 2 * HW - 1]);
        const int s = s0 + i, lo = (s - HW) < 0 ? 0 : (s - HW), hi = (s + HW) > slen ? slen : (s + HW); const float inv = 1.0f / (float)(hi - lo); const u32x4 a = r[i + HW];
        u32x4 o; o.x = cvt_pk_bf16(sum[0] * inv - bf_lo(a.x), sum[1] * inv - bf_hi(a.x)); o.y = cvt_pk_bf16(sum[2] * inv - bf_lo(a.y), sum[3] * inv - bf_hi(a.y));
        o.z = cvt_pk_bf16(sum[4] * inv - bf_lo(a.z), sum[5] * inv - bf_hi(a.z)); o.w = cvt_pk_bf16(sum[6] * inv - bf_lo(a.w), sum[7] * inv - bf_hi(a.w));
        *(u32x4*)(PO + (size_t)(sb + s) * 1024 + c) = o;
        POOL_ACC(-, r[i]); }
#undef POOL_ACC
}
__device__ __forceinline__ void pooled_items(Frame& F, int Mrows) {
    const bf16* P = (const bf16*)(F.ws + WS_P); bf16* PO = (bf16*)(F.ws + WS_POOLED);
    const int nwi = (Mrows / 32) * 4;
    for (int wi = F.vcu * NWAVES + F.wave; wi < nwi; wi += F.G * NWAVES) {
        const int g = wi & 3, rblk = (wi >> 2) * 2 + (F.lane >> 5), r0 = rblk * 16, c = g * 256 + (F.lane & 31) * 8;
        int sb, s0, slen; if (r0 < MLAT) { sb = r0 & ~(SEQ - 1); s0 = r0 & (SEQ - 1); slen = SEQ; } else { const int rr = r0 - MLAT; sb = MLAT + (rr & ~(CTXL - 1)); s0 = rr & (CTXL - 1); slen = CTXL; }
        if (g == 0) pool_block<1>(P, PO, sb, slen, s0, c); else if (g == 1) pool_block<2>(P, PO, sb, slen, s0, c); else if (g == 2) pool_block<4>(P, PO, sb, slen, s0, c); else pool_block<8>(P, PO, sb, slen, s0, c);
    }
}

struct QSeg { int d; int lo; int n; };
constexpr int NQSEG = 15;
__host__ __device__ constexpr QSeg qseg(int i) {
    return i == 0 ? QSeg{0, 0, 6144} : i == 1 ? QSeg{5, 0, 64} : i == 2 ? QSeg{1, 0, 512} : i == 3 ? QSeg{2, 0, 512} : i == 4 ? QSeg{3, 0, 512} : i == 5 ? QSeg{4, 0, 1024} :
           i == 6 ? QSeg{6, 0, 2816} : i == 7 ? QSeg{7, 0, 2816} : i == 8 ? QSeg{8, 0, 2816} :
           i == 9 ? QSeg{0, 6144, 6144} : i == 10 ? QSeg{5, 64, 64} : i == 11 ? QSeg{1, 512, 512} : i == 12 ? QSeg{2, 512, 512} : i == 13 ? QSeg{3, 512, 512} : i == 14 ? QSeg{4, 1024, 1024} :
           QSeg{0, 0, 0};
}
constexpr int Q_L0MIX = 6144 + 64 + 3 * 512 + 1024, Q_FFN = Q_L0MIX + 3 * 2816, Q_L1MIX = Q_FFN + Q_L0MIX, Q_MOE1 = Q_L1MIX + 2 * 28672, Q_TOTAL = Q_MOE1 + 28672;
constexpr int CW_QCUR = 8192, CW_QDONE = 8256;
__device__ __forceinline__ void q_item(const Args& a, unsigned char* ws, int gi, LAS float* scr, int lane) {
    if (gi >= Q_TOTAL) return;
    int d, it;
    if (gi >= Q_L1MIX) { const int r = gi - Q_L1MIX; d = 9 + r / 28672; it = r % 28672; }
    else { int acc = 0; d = 0; it = 0;
#pragma unroll
        for (int i = 0; i < NQSEG; ++i) { const QSeg q = qseg(i); if (gi >= acc && gi < acc + q.n) { d = q.d; it = q.lo + (gi - acc); } acc += q.n; } }
    TDesc t; get_tdesc(d, a, ws, t); tr_item(t, it, scr, lane);
}
template <int QCH> __device__ __forceinline__ void convert_queue(const Args& a, unsigned char* ws, LAS unsigned char* lds, volatile LAS int* MISCw, int limit, int phase, int G) {
    unsigned* ctl = (unsigned*)(ws + WS_CTL); int tid = threadIdx.x; asm volatile("" : "+v"(tid)); const int wave = __builtin_amdgcn_readfirstlane(tid >> 6), lane = tid & 63;
    LAS float* scr = (LAS float*)(lds + wave * 16640);
    unsigned* cur = ctl + CW_QCUR; unsigned* done = ctl + CW_QDONE + 64 * (phase < 0 ? 0 : phase);
#define Q_TAKE(dst) do { int c_ = -1; const bool go_ = (phase < 0) ? ((int)__hip_atomic_load(cur, __ATOMIC_RELAXED, __HIP_MEMORY_SCOPE_AGENT) < limit) \
            : ((int)__hip_atomic_load(done, __ATOMIC_RELAXED, __HIP_MEMORY_SCOPE_AGENT) < G && (int)__hip_atomic_load(cur, __ATOMIC_RELAXED, __HIP_MEMORY_SCOPE_AGENT) < Q_TOTAL); \
        if (go_) c_ = (int)__hip_atomic_fetch_add(cur, (unsigned)QCH, __ATOMIC_RELAXED, __HIP_MEMORY_SCOPE_AGENT); dst = (c_ >= 0 && c_ < Q_TOTAL) ? c_ : -1; } while (0)
    if (phase >= 0 && tid == 0) __hip_atomic_fetch_add(done, 1u, __ATOMIC_RELAXED, __HIP_MEMORY_SCOPE_AGENT);
    if (tid == 0) { int c0; Q_TAKE(c0); MISCw[0] = c0; }
    __syncthreads();
    for (int it = 0;; ++it) {
        const int c = MISCw[it & 1];
        if (c < 0) break;
        int nx = -1; if (tid == 0) Q_TAKE(nx);
#pragma unroll 1
        for (int j = 0; j < QCH / 8; ++j) q_item(a, ws, c + j * 8 + wave, scr, lane);
        if (tid == 0) MISCw[(it + 1) & 1] = nx;
        __syncthreads();
    }
#undef Q_TAKE
    __syncthreads();
}
__device__ __forceinline__ void convert_until(const Args& a, unsigned char* ws, LAS unsigned char* lds, volatile LAS int* MISCw, int limit) { convert_queue<16>(a, ws, lds, MISCw, limit, -1, 0); }
__device__ __forceinline__ void convert_while(const Args& a, unsigned char* ws, LAS unsigned char* lds, volatile LAS int* MISCw, int p, int G) { convert_queue<32>(a, ws, lds, MISCw, 0, p, G); }

constexpr int N_PHASES = 21;
__global__ void __launch_bounds__(NWAVES * 64, 2) fwd_kernel(Args args) {
    extern __shared__ __attribute__((aligned(16))) unsigned char lds_raw[];
    Frame F;
    F.lds = (LAS unsigned char*)lds_raw; F.ws = args.ws; F.a = &args;
    F.tid = threadIdx.x; F.lane = F.tid & 63; F.wave = __builtin_amdgcn_readfirstlane(F.tid >> 6);
    F.G = gridDim.x; { const int bx = blockIdx.x; F.vcu = (F.G % 8 == 0) ? (bx % 8) * (F.G / 8) + bx / 8 : bx; }
    volatile LAS unsigned* MISC = (volatile LAS unsigned*)(F.lds + MISC_OFF);
    LAS int* TILE_E = (LAS int*)(F.lds + MISC_OFF + 64);
    volatile LAS int* QW = (volatile LAS int*)(F.lds + MISC_OFF + 32);
    unsigned* ctl = (unsigned*)(args.ws + WS_CTL);
    if (F.tid < 4) MISC[F.tid] = 0u;
    __syncthreads();
    XcdBarrier bar; bar.bar = ctl + CW_BAR; bar.x = 0; bar.st = nullptr;
    const int lo = args.ph_lo, hi = args.ph_hi;
    if (hi - lo > 1) bar = xcd_barrier_post(ctl + CW_BAR, MISC);
#ifndef PHASE_MASK
#define PHASE_MASK 0xffffffffu
#endif
#define IN(k) ((((PHASE_MASK) >> (k)) & 1u) && lo <= (k) && (k) < hi)
#define SEAM(k) do { if (IN(k) && IN((k) + 1)) xcd_barrier(bar); } while (0)
    const int gw = F.vcu * NWAVES + F.wave, NGW = F.G * NWAVES;
#define WSPTRS unsigned char* ws = args.ws; asm volatile("" : "+s"(ws)); \
    float* MOD = (float*)(ws + WS_MOD); float* X = (float*)(ws + WS_X); bf16* H = (bf16*)(ws + WS_H); bf16* P = (bf16*)(ws + WS_P); bf16* POOLED = (bf16*)(ws + WS_POOLED); bf16* CAT = (bf16*)(ws + WS_CAT); \
    bf16* MERGED = (bf16*)(ws + WS_MERGED); bf16* ACT = (bf16*)(ws + WS_ACT); bf16* ASORT = (bf16*)(ws + WS_ASORT); bf16* ACTS = (bf16*)(ws + WS_ACTS); float* YSORT = (float*)(ws + WS_YSORT); \
    int* TOKE = (int*)(ws + WS_TOK + TOK_E); f32x2* TOKW = (f32x2*)(ws + WS_TOK + TOK_W); int* SLOT = (int*)(ws + WS_TOK + TOK_SLOT); int* CNT = (int*)(ws + WS_TOK + TOK_CNT); int* MINFO = (int*)(ws + WS_TOK + TOK_INFO); \
    (void)MOD; (void)X; (void)H; (void)P; (void)POOLED; (void)CAT; (void)MERGED; (void)ACT; (void)ASORT; (void)ACTS; (void)YSORT; (void)TOKE; (void)TOKW; (void)SLOT; (void)CNT; (void)MINFO;

    if (IN(0)) { WSPTRS
        frame_refresh(F);
        mod_sil(F);
        for (int u = blockIdx.x; u < 128; u += F.G) mod_unit(F, u);
    }
    SEAM(0);

#define LAYER_PHASES(L, PB)                                                                                                                                         \
                                                                       \
    if (IN(PB + 0)) { WSPTRS if (L == 1) convert_until(args, ws, F.lds, QW, Q_L1MIX); frame_refresh(F);                                                                                                                             \
        const int Mrows = MTOT;                                                                                                                                     \
        for (int m = gw; m < Mrows; m += NGW) {                                                                                                                     \
            const float* xrow = (L == 0) ? (m < MLAT ? args.in[I_X] + (size_t)m * DM : args.in[I_CTX] + (size_t)(m - MLAT) * DM) : X + (size_t)m * DM;              \
            const int bidx = m < MLAT ? m / SEQ : NB; const float* md = MOD + ((size_t)L * 5 + bidx) * (6 * DM);                                                    \
            f32x4 hv[8]; normmod_row<false, F8_GATES>(xrow, args.in[I_N1G] + (size_t)L * DM, md, md + DM, H + (size_t)m * DM, F.lane, hv, ws + WS_H8 + (size_t)m * DM); } \
        if (L == 0) {                \
            __syncthreads(); mod_sil(F); for (int u = 128 + blockIdx.x; u < 768; u += F.G) mod_unit(F, u);                                                          \
            convert_until(args, ws, F.lds, QW, 6144); }                                                                                                             \
    }                                                                                                                                                               \
    SEAM(PB + 0);                                                                                                                                                   \
                                                                                                           \
    if (IN(PB + 1)) { WSPTRS                                                                                                                                              \
        pg8::Order S; S.init((L == 0) ? MTOT / 256 : MLAT / 256, INW / 256, F.G, (int)blockIdx.x, H, 256L * DM * 2, (const bf16*)(ws + WS_WIN) + (size_t)L * INW * DM, 256L * DM * 2); \
        if (L == 1 && !F8_QKV) { S.xM0 = MLAT / 256; S.xNm = 8; S.xN0 = OFF_K / 256; S.xCnt = (MCTX / 256) * 8; }                                                   \
        if (F8_GATES) { S.nN = IN_SPLIT / 256; S.nwg = S.nM * S.nN; }                                                    \
        pg8::EpiInProj E{P, 0, 1.0f};                                                                                                                               \
        pg8::gemm_phase<pg8::EpiInProj, pg8::Order, true, false>(F.lds, DM * 2, DM * 2, DM * 2, S, E);                                                              \
        if (F8_GATES) {            \
            pg8::Order S8; S8.init((L == 0) ? MTOT / 256 : MLAT / 256, (INW - IN_SPLIT) / 256, F.G, (L == 0 || F8_QKV) ? F.G - 1 - (int)blockIdx.x : (int)blockIdx.x, ws + WS_H8, 256L * DM, ws + WS_WIN8 + (size_t)L * (INW - IN_SPLIT) * DM, 256L * DM); \
            if (L == 1 && !F8_QKV) S8.skip = (MCTX / 256) * 8;     \
            if (L == 1 && F8_QKV) { S8.xM0 = MLAT / 256; S8.xNm = 8; S8.xN0 = (OFF_K - IN_SPLIT) / 256; S8.xCnt = (MCTX / 256) * 8; }                  \
            pg8::EpiInProj E8{P, IN_SPLIT / 256, FP8_INV};                                                                                                            \
            pg8::gemm_phase<pg8::EpiInProj, pg8::Order, true, false, true>(F.lds, DM, DM, DM, S8, E8); }                                                              \
        convert_while(args, ws, F.lds, QW, PB + 1, F.G);                                                                    \
    }                                                                                                                                                               \
    SEAM(PB + 1);                                                                                                                                                   \
                                                              \
    if (IN(PB + 2)) { WSPTRS if (L == 0) convert_until(args, ws, F.lds, QW, Q_L0MIX); frame_refresh(F);                                                                                                                             \
        float lam; const float lambda_init = (L == 0) ? 0.2f : 0.35550906759f;                                                                                      \
        { float s1 = 0.f, s2 = 0.f; for (int i = 0; i < 64; ++i) { s1 += args.in[I_LQ1][L * 64 + i] * args.in[I_LK1][L * 64 + i]; s2 += args.in[I_LQ2][L * 64 + i] * args.in[I_LK2][L * 64 + i]; } \
          lam = __expf(s1) - __expf(s2) + lambda_init; }                                                                                                            \
        const float* subg = args.in[I_SUBG] + L * 128;                                                                                                              \
        for (int U = F.vcu; U < 512; U += F.G) { const int bh = U >> 4, qb = U & 15, b = bh >> 3, h = bh & 7;                                                       \
            const bf16* Qb = P + (size_t)(b * SEQ + qb * 128) * INW + OFF_Q + h * 128;                                                                              \
            const bf16* K0 = P + (size_t)(b * SEQ) * INW + OFF_K + h * 128; const bf16* K1 = P + (size_t)(MLAT + b * CTXL) * INW + OFF_K + h * 128;                \
            att::diff_attn_unit(Qb, K0, SEQ / 64, K1, CTXL / 64, CAT + (size_t)(b * SEQ + qb * 128) * 3072 + 2048 + h * 128, 3072, lam, subg, 1.0f - lambda_init, (char*)lds_raw); } \
        if (L == 0) { for (int U = F.vcu - (F.G - 64); U < 64; U += F.G) { if (U < 0) continue; const int bh = U >> 1, qb = U & 1, b = bh >> 3, h = bh & 7;                                          \
            const bf16* Qb = P + (size_t)(MLAT + b * CTXL + qb * 128) * INW + OFF_Q + h * 128; const bf16* K1 = P + (size_t)(MLAT + b * CTXL) * INW + OFF_K + h * 128; \
            att::diff_attn_unit(Qb, K1, CTXL / 64, K1, 0, CAT + (size_t)(MLAT + b * CTXL + qb * 128) * 3072 + 2048 + h * 128, 3072, lam, subg, 1.0f - lambda_init, (char*)lds_raw); } } \
        { const int nsgu = ((L == 0) ? MTOT : MLAT) / 128 * 8; for (int U = F.vcu; U < nsgu; U += F.G) sgu_unit(F, L, U >> 3, U & 7); }                              \
        pooled_items(F, (L == 0) ? MTOT : MLAT); __syncthreads(); convert_while(args, ws, F.lds, QW, PB + 2, F.G);                                                  \
    }                                                                                                                                                               \
    SEAM(PB + 2);                                                                                                                                                   \
                                                                        \
    if (IN(PB + 3)) { WSPTRS                                                                                                                                              \
        pg8::Order S; S.init(((L == 0) ? MTOT : MLAT) / 256, 4, F.G, (int)blockIdx.x, POOLED, 256L * 1024 * 2, (const bf16*)(ws + WS_WPOOL) + (size_t)L * 4 * 65536, 65536L * 2); S.aPn = 256 * 2; \
        pg8::EpiScaleBf16 E{CAT, 3072, args.in[I_POOLS] + (size_t)L * 1024};                                                                                        \
        int Kp = 512; asm volatile("" : "+s"(Kp));                                                    \
        pg8::gemm_phase<pg8::EpiScaleBf16, pg8::Order, false, false>(F.lds, Kp, 2048, 512, S, E);                                                                   \
    }                                                                                                                                                               \
    SEAM(PB + 3);                                                                                                                                                   \
                                                                        \
    if (IN(PB + 4)) { WSPTRS                                                                                                                                              \
        pg8::Order S; S.init(((L == 0) ? MTOT : MLAT) / 256, DM / 256, F.G, (int)blockIdx.x, CAT, 256L * 3072 * 2, (const bf16*)(ws + WS_WPC) + (size_t)L * 2048 * 3072, 256L * 3072 * 2); \
        pg8::EpiMerge E{P + OFF_G, MERGED};                                                                                                                         \
        pg8::gemm_phase<pg8::EpiMerge, pg8::Order, true, true>(F.lds, 6144, 6144, 6144, S, E); convert_while(args, ws, F.lds, QW, PB + 4, F.G);                                                                     \
    }                                                                                                                                                               \
    SEAM(PB + 4);                                                                                                                                                   \
                                                                                           \
    if (IN(PB + 5)) { WSPTRS                                                                                                                                              \
        pg8::Order S; S.init(((L == 0) ? MTOT : MLAT) / 256, DM / 256, F.G, (int)blockIdx.x, MERGED, 256L * DM * 2, (const bf16*)(ws + WS_WO) + (size_t)L * DM * DM, 256L * DM * 2); \
        pg8::EpiResid E{(L == 0) ? args.in[I_X] : X, (L == 0) ? args.in[I_CTX] : X + (size_t)MLAT * DM, X, MOD + (size_t)L * 5 * (6 * DM) + 2 * DM, 1.0f};          \
        pg8::gemm_phase<pg8::EpiResid, pg8::Order, true, false>(F.lds, DM * 2, DM * 2, DM * 2, S, E); convert_while(args, ws, F.lds, QW, PB + 5, F.G);                                                              \
    }                                                                                                                                                               \
    SEAM(PB + 5);

    LAYER_PHASES(0, 1)
    if (IN(7)) { WSPTRS
        convert_until(args, ws, F.lds, QW, Q_FFN);
        frame_refresh(F);
        for (int m = gw; m < MTOT; m += NGW) { const int bidx = m < MLAT ? m / SEQ : NB; const float* md = MOD + ((size_t)0 * 5 + bidx) * (6 * DM);
            f32x4 hv[8]; normmod_row<F8_FFN1>(X + (size_t)m * DM, args.in[I_N2G], md + 3 * DM, md + 4 * DM, (bf16*)((unsigned char*)H + (size_t)m * DM * (F8_FFN1 ? 1 : 2)), F.lane, hv); }
    }
    SEAM(7);
    if (IN(8)) { WSPTRS
        constexpr int es = F8_FFN1 ? 1 : 2;
        pg8::Order S; S.init(MTOT / 256, 2 * DFF / 256, F.G, (int)blockIdx.x, H, 256L * DM * es, ws + WS_W13, 256L * DM * es);
        pg8::EpiSwiGLU<F8_FFN1, F8_FFN2> E{(unsigned char*)ACT, DFF};
        pg8::gemm_phase<pg8::EpiSwiGLU<F8_FFN1, F8_FFN2>, pg8::Order, true, false, F8_FFN1>(F.lds, DM * es, DM * es, DM * es, S, E); convert_while(args, ws, F.lds, QW, 8, F.G);
    }
    SEAM(8);
    if (IN(9)) { WSPTRS
        constexpr int es = F8_FFN2 ? 1 : 2;
        pg8::Order S; S.init(MTOT / 256, DM / 256, F.G, (int)blockIdx.x, ACT, 256L * DFF * es, ws + WS_W2, 256L * DFF * es);
        pg8::EpiResid E{X, X + (size_t)MLAT * DM, X, MOD + 5 * DM, F8_FFN2 ? FP8_INV : 1.0f};
        pg8::gemm_phase<pg8::EpiResid, pg8::Order, true, false, F8_FFN2>(F.lds, DFF * es, DFF * es, DFF * es, S, E); convert_while(args, ws, F.lds, QW, 9, F.G);
    }
    SEAM(9);

    LAYER_PHASES(1, 10)
    const int TPB = (MLAT + F.G - 1) / F.G;
    if (IN(16)) { WSPTRS frame_refresh(F);
        LAS float* wrT = (LAS float*)F.lds;
        LAS int* tokl = (LAS int*)(F.lds + 65536);
        for (int idx = F.tid; idx < DM * NE; idx += 512) wrT[(idx & 7) * DM + (idx >> 3)] = args.in[I_ROUTER][idx];
        __syncthreads();
        const int t0 = blockIdx.x * TPB;
        for (int tt = F.wave; tt < TPB; tt += NWAVES) { const int m = t0 + tt; if (m >= MLAT) break;
            const float* md = MOD + ((size_t)1 * 5 + m / SEQ) * (6 * DM);
            f32x4 hv[8]; normmod_row<F8_MOE1>(X + (size_t)m * DM, args.in[I_N2G] + DM, md + 3 * DM, md + 4 * DM, (bf16*)((unsigned char*)H + (size_t)m * DM * (F8_MOE1 ? 1 : 2)), F.lane, hv);
            int ln = F.lane; asm volatile("" : "+v"(ln));
            float b1 = -3.0e38f, b2 = -3.0e38f; int i1 = 0, i2 = 0;
#pragma unroll 1
            for (int e = 0; e < NE; ++e) { float sx = 0.f;
#pragma unroll
                for (int j = 0; j < 8; ++j) { const f32x4 w = *(const LAS f32x4*)(wrT + e * DM + (ln + 64 * j) * 4); sx += (hv[j][0] * w[0] + hv[j][1] * w[1]) + (hv[j][2] * w[2] + hv[j][3] * w[3]); }
                const float lge = wave_sum(sx);
                if (lge > b1) { b2 = b1; i2 = i1; b1 = lge; i1 = e; } else if (lge > b2) { b2 = lge; i2 = e; } }
            const float w1 = 1.0f / (1.0f + __expf(b2 - b1));
            if (F.lane == 0) { TOKE[m] = i1 | (i2 << 8); TOKW[m] = (f32x2){w1, 1.0f - w1}; tokl[tt] = i1 | (i2 << 8); } }
        __syncthreads();
        if (F.tid < NE) { int c = 0; for (int tt = 0; tt < TPB; ++tt) { if (t0 + tt < MLAT) { const int te = tokl[tt]; c += ((te & 255) == F.tid) + ((te >> 8) == F.tid); } } CNT[blockIdx.x * NE + F.tid] = c; }
    }
    SEAM(16);
    if (IN(17)) { WSPTRS convert_until(args, ws, F.lds, QW, Q_MOE1); frame_refresh(F);
        LAS int* cl = (LAS int*)F.lds;
        LAS int* info = (LAS int*)(F.lds + 16384);
        LAS int* tokl = (LAS int*)(F.lds + 32768);
        for (int idx = F.tid; idx < F.G * NE; idx += 512) cl[idx] = CNT[idx];
        if (F.tid < TPB && (int)blockIdx.x * TPB + F.tid < MLAT) tokl[F.tid] = TOKE[blockIdx.x * TPB + F.tid];
        __syncthreads();
        if (F.tid < 64) {
            const int e = F.tid & 7, part = F.tid >> 3; int tot = 0, pre = 0;
            for (int b = part; b < F.G; b += 8) { const int c = cl[b * NE + e]; tot += c; if (b < (int)blockIdx.x) pre += c; }
#pragma unroll
            for (int o = 8; o < 64; o <<= 1) { tot += __shfl_xor(tot, o); pre += __shfl_xor(pre, o); }
            if (part == 0) { info[e] = tot; info[8 + e] = pre; } }
        __syncthreads();
        if (F.tid == 0) { int ts = 0; for (int e = 0; e < NE; ++e) { info[16 + e] = ts; ts += (info[e] + 255) >> 8; }
            if (blockIdx.x == 0) { for (int e = 0; e < NE; ++e) { MINFO[e] = (info[e] + 255) >> 8; MINFO[8 + e] = info[16 + e]; } MINFO[16] = ts; }
            int run[NE];
#pragma unroll
            for (int e = 0; e < NE; ++e) run[e] = 0;
            const int t0 = blockIdx.x * TPB;
            for (int tt = 0; tt < TPB; ++tt) { const int m = t0 + tt; if (m >= MLAT) break; const int te = tokl[tt];
#pragma unroll
                for (int k = 0; k < 2; ++k) { const int e = k ? (te >> 8) : (te & 255); int r = 0;
#pragma unroll
                    for (int ee = 0; ee < NE; ++ee) if (ee == e) { r = run[ee]; run[ee] = r + 1; }
                    const int slot = info[16 + e] * 256 + info[8 + e] + r; info[32 + 2 * tt + k] = slot; SLOT[2 * m + k] = slot; } } }
        __syncthreads();
        { const int t0 = blockIdx.x * TPB;
          for (int pr = F.wave; pr < 2 * TPB; pr += NWAVES) { const int m = t0 + (pr >> 1); if (m >= MLAT) break; const int slot = info[32 + pr];
              constexpr int es = F8_MOE1 ? 1 : 2;
              const u32x4* s = (const u32x4*)((const unsigned char*)H + (size_t)m * DM * es); u32x4* d = (u32x4*)((unsigned char*)ASORT + (size_t)slot * DM * es);
#pragma unroll
              for (int i = 0; i < 2 * es; ++i) d[F.lane + 64 * i] = s[F.lane + 64 * i]; } }
    }
    SEAM(17);
    if (IN(18) || IN(19)) { WSPTRS
        frame_refresh(F);
        if (F.tid < MOE_TILES) { int e = 0;
#pragma unroll
            for (int ee = 1; ee < NE; ++ee) if (F.tid >= MINFO[8 + ee]) e = ee;
            TILE_E[F.tid] = e; }
        __syncthreads();
    }
    if (IN(18)) { WSPTRS
        constexpr int es = F8_MOE1 ? 1 : 2;
        pg8::Order S; S.init(__builtin_amdgcn_readfirstlane(MINFO[16]), 2 * DFE / 256, F.G, (int)blockIdx.x, ASORT, 256L * DM * es, ws + WS_MW13, 256L * DM * es); S.tileE = TILE_E; S.bExp = 2L * DFE * DM * es;
        pg8::EpiSwiGLU<F8_MOE1, F8_MOE2> E{(unsigned char*)ACTS, DFE};
        pg8::gemm_phase<pg8::EpiSwiGLU<F8_MOE1, F8_MOE2>, pg8::Order, true, false, F8_MOE1>(F.lds, DM * es, DM * es, DM * es, S, E);
        convert_until(args, ws, F.lds, QW, Q_TOTAL);
    }
    SEAM(18);
    if (IN(19)) { WSPTRS
        constexpr int es = F8_MOE2 ? 1 : 2;
        pg8::Order S; S.init(__builtin_amdgcn_readfirstlane(MINFO[16]), 2 * DM / 256, F.G, (int)blockIdx.x, ACTS, 256L * DFE * es, ws + WS_MW2, 256L * DFE * es); S.tileE = TILE_E; S.bExp = (long)DM * DFE * es;
        S.kShift = 3; S.kOff = (long)(DFE / 2) * es;
        pg8::EpiPartBf16 E{(bf16*)YSORT, (size_t)MOE_ROWS * DM, F8_MOE2 ? FP8_INV : 1.0f};
        pg8::gemm_phase<pg8::EpiPartBf16, pg8::Order, true, false, F8_MOE2>(F.lds, (DFE / 2) * es, DFE * es, DFE * es, S, E);
    }
    SEAM(19);
    if (IN(20)) { WSPTRS
        frame_refresh(F);
        for (int m = gw; m < MLAT; m += NGW) {
            int ln = F.lane; asm volatile("" : "+v"(ln));
            const float* gt = MOD + ((size_t)1 * 5 + m / SEQ) * (6 * DM) + 5 * DM; const f32x2 tw = TOKW[m]; const int s0 = SLOT[2 * m], s1 = SLOT[2 * m + 1];
            const f32x4* xr = (const f32x4*)(X + (size_t)m * DM); const bf16* YB = (const bf16*)YSORT; constexpr size_t YP = (size_t)MOE_ROWS * DM;
            const u32x2* y0 = (const u32x2*)(YB + (size_t)s0 * DM); const u32x2* y1 = (const u32x2*)(YB + (size_t)s1 * DM); const u32x2* y2 = (const u32x2*)(YB + YP + (size_t)s0 * DM); const u32x2* y3 = (const u32x2*)(YB + YP + (size_t)s1 * DM);
            f32x4 v[8]; float ss = 0.f;
#pragma unroll
            for (int j = 0; j < 8; ++j) { const int c4 = ln + 64 * j; const u32x2 a0 = y0[c4], a1 = y1[c4], a2 = y2[c4], a3 = y3[c4];
                const f32x4 e0 = (f32x4){bf_lo(a0.x) + bf_lo(a2.x), bf_hi(a0.x) + bf_hi(a2.x), bf_lo(a0.y) + bf_lo(a2.y), bf_hi(a0.y) + bf_hi(a2.y)};
                const f32x4 e1 = (f32x4){bf_lo(a1.x) + bf_lo(a3.x), bf_hi(a1.x) + bf_hi(a3.x), bf_lo(a1.y) + bf_lo(a3.y), bf_hi(a1.y) + bf_hi(a3.y)};
                v[j] = xr[c4] + ((const f32x4*)gt)[c4] * (tw[0] * e0 + tw[1] * e1);
                ss += (v[j][0] * v[j][0] + v[j][1] * v[j][1]) + (v[j][2] * v[j][2] + v[j][3] * v[j][3]); }
            const float rstd = 1.0f / sqrtf(wave_sum(ss) * (1.0f / DM) + EPS);
#pragma unroll
            for (int j = 0; j < 8; ++j) { const int c4 = ln + 64 * j; __builtin_nontemporal_store(v[j] * rstd * ((const f32x4*)args.in[I_FNG])[c4], (f32x4*)(args.out + (size_t)m * DM) + c4); }
        }
    }
#undef IN
#undef SEAM
}

extern "C" void kernel_launch(void* const* d_in, const int* in_sizes, int n_in, void* d_out, int out_size, void* d_ws, size_t ws_size, hipStream_t stream) {
    static int grid = 0;
    if (grid == 0) {
        if (n_in != 31 || out_size != MLAT * DM || ws_size < WS_END) { fprintf(stderr, "kernel_launch: unexpected shapes: n_in %d out %d ws %zu (need %zu)\n", n_in, out_size, ws_size, (size_t)WS_END); grid = -1; return; }
        int dev = 0, cus = 0, per_cu = 0;
        if (hipGetDevice(&dev) != hipSuccess || hipDeviceGetAttribute(&cus, hipDeviceAttributeMultiprocessorCount, dev) != hipSuccess) { grid = -1; return; }
        if (hipFuncSetAttribute((const void*)fwd_kernel, hipFuncAttributeMaxDynamicSharedMemorySize, LDS_BYTES) != hipSuccess) { fprintf(stderr, "kernel_launch: hipFuncSetAttribute failed\n"); grid = -1; return; }
        if (hipOccupancyMaxActiveBlocksPerMultiprocessor(&per_cu, (const void*)fwd_kernel, NWAVES * 64, LDS_BYTES) != hipSuccess || per_cu < 1) fprintf(stderr, "kernel_launch: occupancy query says %d\n", per_cu);
        (void)hipGetLastError();
        grid = cus > 256 ? 256 : cus;
    }
    if (grid < 0) return;
    (void)hipMemsetAsync((char*)d_ws + WS_CTL, 0, CTL_ZERO_BYTES, stream);
    Args a{};
    for (int i = 0; i < 31; ++i) a.in[i] = (const float*)d_in[i];
    a.out = (float*)d_out; a.ws = (unsigned char*)d_ws;
#if defined(PROBE_K)
    a.ph_lo = 0; a.ph_hi = PROBE_K + 1; hipLaunchKernelGGL(fwd_kernel, dim3(grid), dim3(NWAVES * 64), LDS_BYTES, stream, a);
    (void)hipMemsetAsync((char*)d_ws + WS_CTL, 0, CTL_ZERO_BYTES, stream);
    a.ph_lo = PROBE_K; a.ph_hi = N_PHASES; hipLaunchKernelGGL(fwd_kernel, dim3(grid), dim3(NWAVES * 64), LDS_BYTES, stream, a);
#elif MK_N_LAUNCHES == 1
    a.ph_lo = 0; a.ph_hi = N_PHASES;
    hipLaunchKernelGGL(fwd_kernel, dim3(grid), dim3(NWAVES * 64), LDS_BYTES, stream, a);
#else
    for (int p = 0; p < N_PHASES; ++p) { a.ph_lo = p; a.ph_hi = p + 1; hipLaunchKernelGGL(fwd_kernel, dim3(grid), dim3(NWAVES * 64), LDS_BYTES, stream, a); }
#endif
    const hipError_t le = hipPeekAtLastError();
    if (le != hipSuccess) fprintf(stderr, "kernel_launch: launch failed: %s\n", hipGetErrorName(le));
}
```

```cpp
#include <hip/hip_runtime.h>
#include <cstdio>
#include <cstdint>

#ifndef MK_N_LAUNCHES
#define MK_N_LAUNCHES 1
#endif

#define LAS __attribute__((address_space(3)))
#define GAS __attribute__((address_space(1)))
typedef unsigned short bf16;
typedef short bf16x8 __attribute__((ext_vector_type(8)));
typedef short s16x4 __attribute__((ext_vector_type(4)));
typedef float f32x4 __attribute__((ext_vector_type(4)));
typedef float f32x2 __attribute__((ext_vector_type(2)));
typedef float f32x16 __attribute__((ext_vector_type(16)));
typedef unsigned u32x4 __attribute__((ext_vector_type(4)));
typedef unsigned u32x2 __attribute__((ext_vector_type(2)));
typedef int i32x8 __attribute__((ext_vector_type(8)));
typedef int i32x4 __attribute__((ext_vector_type(4)));

constexpr int DM = 2048, NB = 4, SEQ = 2048, CTXL = 256;
constexpr int MLAT = NB * SEQ, MCTX = NB * CTXL, MTOT = MLAT + MCTX;
constexpr int INW = 12288, OFF_A = 0, OFF_B = 1024, OFF_Q = 3072, OFF_K = 4096, OFF_V = 5120, OFF_G = 6144;
constexpr int DFF = 5632, NE = 8, DFE = 7168;
constexpr int NHEAD = 8;
constexpr float EPS = 1e-6f;
constexpr int MOE_ROWS = 2 * MLAT + NE * 256;
constexpr int MOE_TILES = MOE_ROWS / 256;

constexpr size_t MiB = 1u << 20;
constexpr size_t WS_CTL = 0, CTL_ZERO_BYTES = 1 * MiB;
constexpr size_t WS_MOD = 1 * MiB;
constexpr size_t WS_WIN = 2 * MiB;
constexpr size_t WS_WPC = WS_WIN + 96 * MiB;
constexpr size_t WS_WO = WS_WPC + 24 * MiB;
constexpr size_t WS_WPOOL = WS_WO + 16 * MiB;
constexpr size_t WS_W13 = WS_WPOOL + 1 * MiB;
constexpr size_t WS_W2 = WS_W13 + 44 * MiB;
constexpr size_t WS_MW13 = WS_W2 + 22 * MiB;
constexpr size_t WS_MW2 = WS_MW13 + 448 * MiB;
constexpr size_t WS_X = WS_MW2 + 224 * MiB;
constexpr size_t WS_H = WS_X + 72 * MiB;
constexpr size_t WS_P = WS_H + 36 * MiB;
constexpr size_t WS_POOLED = WS_P + 216 * MiB;
constexpr size_t WS_CAT = WS_POOLED + 18 * MiB;
constexpr size_t WS_MERGED = WS_CAT + 54 * MiB;
constexpr size_t WS_ACT = WS_MERGED + 36 * MiB;
constexpr size_t WS_ASORT = WS_ACT + 99 * MiB;
constexpr size_t WS_YSORT = WS_ASORT + 72 * MiB;
constexpr size_t WS_TOK = WS_YSORT + 144 * MiB;
constexpr size_t WS_H8 = WS_TOK + 1 * MiB;
constexpr size_t WS_WIN8 = WS_H8 + 18 * MiB;
constexpr size_t WS_END = WS_WIN8 + 36 * MiB;
constexpr size_t WS_ACTS = WS_P;
static_assert((size_t)MOE_ROWS * DFE * 2 <= 288 * MiB, "ACT_sorted overlay");
constexpr size_t TOK_E = 0, TOK_W = 65536, TOK_SLOT = 131072, TOK_CNT = 196608, TOK_INFO = 204800;

constexpr int CW_BAR = 4096;

constexpr int LDS_BYTES = 147456;
constexpr int MISC_OFF = LDS_BYTES - 2048;
constexpr int NWAVES = 8;

__device__ __forceinline__ unsigned cvt_pk_bf16(float lo, float hi) { unsigned r; asm volatile("v_cvt_pk_bf16_f32 %0, %1, %2" : "=v"(r) : "v"(lo), "v"(hi)); return r; }
__device__ __forceinline__ bf16x8 as_bf16x8(i32x4 v) { return __builtin_bit_cast(bf16x8, v); }
__device__ __forceinline__ float bf_lo(unsigned w) { return __uint_as_float(w << 16); }
__device__ __forceinline__ float bf_hi(unsigned w) { return __uint_as_float(w & 0xffff0000u); }
__device__ __forceinline__ float bf2f(bf16 b) { return __uint_as_float(((unsigned)b) << 16); }
template <int CTRL> __device__ __forceinline__ float dpp_xadd(float v) {
    return v + __builtin_bit_cast(float, __builtin_amdgcn_update_dpp(0, __builtin_bit_cast(int, v), CTRL, 0xf, 0xf, false));
}
__device__ __forceinline__ float row16_sum(float v) {
    v = dpp_xadd<0xB1>(v);
    v = dpp_xadd<0x4E>(v);
    v = dpp_xadd<0x141>(v);
    v = dpp_xadd<0x140>(v);
    return v;
}
__device__ __forceinline__ float wave_sum(float v) {
    const int r = __builtin_bit_cast(int, row16_sum(v));
    const float s0 = __builtin_bit_cast(float, __builtin_amdgcn_readlane(r, 0)),  s1 = __builtin_bit_cast(float, __builtin_amdgcn_readlane(r, 16));
    const float s2 = __builtin_bit_cast(float, __builtin_amdgcn_readlane(r, 32)), s3 = __builtin_bit_cast(float, __builtin_amdgcn_readlane(r, 48));
    return (s0 + s1) + (s2 + s3);
}
__device__ __forceinline__ float sigmoid_f(float x) { return __builtin_amdgcn_rcpf(1.0f + __builtin_amdgcn_exp2f(-1.4426950408889634f * x)); }
__device__ __forceinline__ float gelu_tanh_f(float x) { const float u = 0.7978845608028654f * (x + 0.044715f * x * x * x); return x * __builtin_amdgcn_rcpf(1.0f + __builtin_amdgcn_exp2f(-2.8853900817779268f * u)); }
constexpr float FP8_SA = 8.0f, FP8_SW = 64.0f, FP8_INV = 1.0f / (FP8_SA * FP8_SW);
#ifndef F8_MASK
#define F8_MASK 95
#endif
constexpr bool F8_GATES = (F8_MASK & 16) != 0;
constexpr bool F8_QKV = (F8_MASK & 64) != 0;
constexpr int IN_SPLIT = F8_QKV ? 3072 : 6144;
constexpr bool F8_FFN1 = (F8_MASK & 1) != 0, F8_FFN2 = (F8_MASK & 2) != 0, F8_MOE1 = (F8_MASK & 4) != 0, F8_MOE2 = (F8_MASK & 8) != 0;
__device__ __forceinline__ float clamp448(float x) { return __builtin_fminf(__builtin_fmaxf(x, -448.0f), 448.0f); }
__device__ __forceinline__ unsigned pk4_fp8(float a, float b, float c, float d) {
    int v = __builtin_amdgcn_cvt_pk_fp8_f32(clamp448(a), clamp448(b), 0, false); v = __builtin_amdgcn_cvt_pk_fp8_f32(clamp448(c), clamp448(d), v, true); return (unsigned)v; }
#define LDS_WAIT() asm volatile("s_waitcnt lgkmcnt(0)" ::: "memory")
#define VM_WAIT() asm volatile("s_waitcnt vmcnt(0)" ::: "memory")

namespace pg8 {
constexpr int BM = 256, BK = 64, HALF = 128, HTB = HALF * BK * 2, STAGE_BYTES = 8 * HTB, NXCD = 8, WGM = 8;
__host__ __device__ __forceinline__ int lds_byte(int r, int c) { const int st = (r >> 4) * 2 + (c >> 5), rr = r & 15, cc = c & 31, ob = rr * 64 + cc * 2; return st * 1024 + (ob ^ (((ob >> 9) & 1) << 5)); }
__host__ __device__ __forceinline__ void stage_rc(int b, int& R, int& C) { const int st = b / 1024, sb = b % 1024, swz = sb ^ (((sb >> 9) & 1) << 5); R = (st >> 1) * 16 + swz / 64; C = (st & 1) * 32 + (swz % 64) / 2; }
__host__ __device__ __forceinline__ int perm32(int rho) { const int n = rho >> 4, i = rho & 15; return 8 * (i >> 2) + 4 * n + (i & 3); }

struct Unit { const char* A; const char* B; int pm, pn; };

struct Order {
    int nM, nN, nwg, G, c;
    const char* A; const char* B; long aTile, bTile, aPn;
    int xM0, xNm, xN0, xCnt;
    const LAS int* tileE; long bExp;
    int skip;
    int kShift; long kOff;
    __device__ __forceinline__ void init(int nM_, int nN_, int G_, int c_, const void* A_, long aTile_, const void* B_, long bTile_) {
        nM = nM_; nN = nN_; nwg = nM_ * nN_; G = G_; c = c_; A = (const char*)A_; B = (const char*)B_; aTile = aTile_; bTile = bTile_; aPn = 0; xM0 = 0; xNm = 1; xN0 = 0; xCnt = 0; tileE = nullptr; bExp = 0; kShift = 30; kOff = 0; skip = 0; }
    __device__ __forceinline__ bool next(int i, Unit& u) const {
        long L = (long)i * G + c;
        if (skip > 0 && i >= 2) { if (c < skip) return false; L = 2L * G + (long)(i - 2) * (G - skip) + (c - skip); }
        if (L >= (long)nwg + xCnt) return false;
        int pm, pn;
        if (L < nwg) {
            int wgid = (int)L; { const int q = nwg / NXCD, r = nwg % NXCD, xcd = wgid % NXCD, off = wgid / NXCD; wgid = (xcd < r ? xcd * (q + 1) : r * (q + 1) + (xcd - r) * q) + off; }
            const int nig = WGM * nN, gid = wgid / nig, fm = gid * WGM, gsz = (nM - fm) < WGM ? (nM - fm) : WGM;
            pm = fm + ((wgid % nig) % gsz); pn = (wgid % nig) / gsz;
        } else { const int j = (int)(L - nwg); pm = xM0 + j / xNm; pn = xN0 + j % xNm; }
        const int ks = pn >> kShift, pnr = pn & ((1 << kShift) - 1);
        u.pm = pm; u.pn = pn; u.A = A + (long)pm * aTile + (long)pn * aPn + ks * kOff;
        long bo = (long)pnr * bTile + ks * kOff; if (tileE) bo += (long)__builtin_amdgcn_readfirstlane(tileE[pm]) * bExp;
        u.B = B + bo; return true;
    }
};

template <class Epi, class Sched, bool ALIGN_EPI, bool HOOK, bool FP8 = false>
__device__ __forceinline__ void gemm_phase(LAS unsigned char* lds, const int Kb, const int ldaB, const int ldbB, const Sched& S, const Epi& E) {
    int tid = threadIdx.x; asm volatile("" : "+v"(tid));
    const int wid = __builtin_amdgcn_readfirstlane(tid >> 6), lane = tid & 63, wr = wid >> 2, wc = wid & 3, fr = lane & 15, fq = lane >> 4;
    const int nt = Kb / (BK * 2);
    unsigned voffA[2], voffB[2];
#pragma unroll
    for (int i = 0; i < 2; ++i) { int R, C; stage_rc(tid * 16 + i * 8192, R, C); const int Rb = Epi::PERM ? ((R & ~31) + perm32(R & 31)) : R;
        voffA[i] = (unsigned)(R * ldaB + C * 2); voffB[i] = (unsigned)(Rb * ldbB + C * 2); }
    const size_t kstep = (size_t)(BK * 2);
    const size_t hstepA = (size_t)HALF * ldaB, hstepB = (size_t)HALF * ldbB;
    const unsigned ldsbase = (unsigned)__builtin_amdgcn_readfirstlane((int)(unsigned)(uintptr_t)lds + wid * 1024);
    const int aoff = lds_byte(wr * 64 + fr, fq * 8), boff = lds_byte(wc * 32 + fr, fq * 8);
#define PG8_SA(b, h) (((b) * 2 + (h)) * HTB)
#define PG8_SB(b, h) ((4 + (b) * 2 + (h)) * HTB)
#define PG8_STAGE(bufoff, gbase, voff) do { _Pragma("unroll") for (int _i = 0; _i < 2; ++_i) { unsigned _keep; \
        asm volatile("s_mov_b32 %0, m0\n\ts_mov_b32 m0, %3\n\ts_nop 0\n\tglobal_load_lds_dwordx4 %1, %2\n\ts_mov_b32 m0, %0" : "=&s"(_keep) : "v"((voff)[_i]), "s"((const char*)(gbase)), \
                     "s"(ldsbase + (unsigned)((bufoff) + _i * 8192)) : "memory"); } } while (0)
#define PG8_LDA(dst, b, h) do { _Pragma("unroll") for (int m = 0; m < 4; ++m) { dst[m].lo = *(const LAS i32x4*)(lds + PG8_SA(b, h) + aoff + m * 2048); dst[m].hi = *(const LAS i32x4*)(lds + PG8_SA(b, h) + aoff + m * 2048 + 1024); } } while (0)
#define PG8_LDB(dst, b, h) do { _Pragma("unroll") for (int n = 0; n < 2; ++n) { dst[n].lo = *(const LAS i32x4*)(lds + PG8_SB(b, h) + boff + n * 2048); dst[n].hi = *(const LAS i32x4*)(lds + PG8_SB(b, h) + boff + n * 2048 + 1024); } } while (0)
#define PG8_MMA(ai, bj, At, Bt) do { __builtin_amdgcn_s_setprio(3); _Pragma("unroll") for (int m = 0; m < 4; ++m) _Pragma("unroll") for (int n = 0; n < 2; ++n) { \
        if constexpr (FP8) asm volatile("v_mfma_f32_16x16x128_f8f6f4 %0, %1, %2, %0" : "+v"(acc[ai][bj][m][n]) : "v"(Bt[n]), "v"(At[m]));   \
        else { acc[ai][bj][m][n] = __builtin_amdgcn_mfma_f32_16x16x32_bf16(as_bf16x8(Bt[n].lo), as_bf16x8(At[m].lo), acc[ai][bj][m][n], 0, 0, 0); \
               acc[ai][bj][m][n] = __builtin_amdgcn_mfma_f32_16x16x32_bf16(as_bf16x8(Bt[n].hi), as_bf16x8(At[m].hi), acc[ai][bj][m][n], 0, 0, 0); } } \
        __builtin_amdgcn_s_setprio(0); } while (0)
#define PG8_WAIT_V(n) asm volatile("s_waitcnt vmcnt(" #n ")" ::: "memory")
#define PG8_WAIT_L(n) asm volatile("s_waitcnt lgkmcnt(" #n ")" ::: "memory")
#define PG8_BAR __builtin_amdgcn_s_barrier()
#define PG8_SCHED __builtin_amdgcn_sched_barrier(0)
    Unit cur, nxt; int ui = 0;
    if (!S.next(0, cur)) return;
    f32x4 acc[2][2][4][2];
#pragma unroll
    for (int a = 0; a < 2; ++a)
#pragma unroll
        for (int b = 0; b < 2; ++b)
#pragma unroll
            for (int m = 0; m < 4; ++m)
#pragma unroll
                for (int n = 0; n < 2; ++n) acc[a][b][m][n] = (f32x4){0.f, 0.f, 0.f, 0.f};
    i32x8 At[4], B0[2], B1[2];
    const char* cA = cur.A; const char* cB = cur.B;
    PG8_STAGE(PG8_SB(0, 0), cB, voffB); PG8_STAGE(PG8_SB(0, 1), cB + hstepB, voffB); PG8_STAGE(PG8_SA(0, 0), cA, voffA); PG8_STAGE(PG8_SA(0, 1), cA + hstepA, voffA);
    if (wr == 1) PG8_BAR;
    PG8_WAIT_V(2); PG8_BAR;
    PG8_STAGE(PG8_SB(1, 0), cB + kstep, voffB); PG8_STAGE(PG8_SA(1, 0), cA + kstep, voffA); PG8_STAGE(PG8_SB(1, 1), cB + hstepB + kstep, voffB);
    PG8_WAIT_V(6); PG8_BAR;
    for (;;) {
        const bool has_next = S.next(ui + 1, nxt);
        const char* nA = has_next ? nxt.A : cA; const char* nB = has_next ? nxt.B : cB;
        for (int t = 0; t < nt; t += 2) {
            const bool last = (t == nt - 2);
            const char* a1 = cA + (size_t)(t + 1) * kstep;
            const char* a2 = last ? nA : cA + (size_t)(t + 2) * kstep; const char* b2 = last ? nB : cB + (size_t)(t + 2) * kstep;
            const char* a3 = a2 + kstep; const char* b3 = b2 + kstep;
            if constexpr (HOOK) { if (t == 16 || t == 32) E.scale(acc, cur, t >> 4, wr, wc, fr, fq); }
            PG8_LDB(B0, 0, 0); PG8_LDB(B1, 0, 1); PG8_SCHED; PG8_LDA(At, 0, 0); PG8_STAGE(PG8_SA(1, 1), a1 + hstepA, voffA);
            PG8_WAIT_V(8); PG8_WAIT_L(0); PG8_BAR; PG8_MMA(0, 0, At, B0); PG8_MMA(0, 1, At, B1); PG8_BAR; PG8_SCHED;
            PG8_LDA(At, 0, 1); PG8_STAGE(PG8_SB(0, 0), b2, voffB); PG8_STAGE(PG8_SB(0, 1), b2 + hstepB, voffB); PG8_STAGE(PG8_SA(0, 0), a2, voffA);
            PG8_WAIT_V(8); PG8_WAIT_L(0); PG8_BAR; PG8_MMA(1, 0, At, B0); PG8_MMA(1, 1, At, B1); PG8_BAR; PG8_SCHED;
            PG8_LDB(B0, 1, 0); PG8_LDB(B1, 1, 1); PG8_SCHED; PG8_LDA(At, 1, 0); PG8_STAGE(PG8_SA(0, 1), a2 + hstepA, voffA);
            PG8_WAIT_V(8); PG8_WAIT_L(0); PG8_BAR; PG8_MMA(0, 0, At, B0); PG8_MMA(0, 1, At, B1); PG8_BAR; PG8_SCHED;
            PG8_LDA(At, 1, 1); PG8_STAGE(PG8_SB(1, 0), b3, voffB); PG8_STAGE(PG8_SB(1, 1), b3 + hstepB, voffB); PG8_STAGE(PG8_SA(1, 0), a3, voffA);
            PG8_WAIT_V(8); PG8_WAIT_L(0); PG8_BAR; PG8_MMA(1, 0, At, B0); PG8_MMA(1, 1, At, B1); PG8_BAR; PG8_SCHED;
        }
        if constexpr (ALIGN_EPI) { if (wr == 0) PG8_BAR; }
        if constexpr (FP8) asm volatile("s_nop 15\n\ts_nop 15\n\ts_nop 15\n\ts_nop 15\n\ts_nop 15" ::: "memory");
        E(acc, cur, wr, wc, fr, fq);
        if (!has_next) break;
#pragma unroll
        for (int a = 0; a < 2; ++a)
#pragma unroll
            for (int b = 0; b < 2; ++b)
#pragma unroll
                for (int m = 0; m < 4; ++m)
#pragma unroll
                    for (int n = 0; n < 2; ++n) acc[a][b][m][n] = (f32x4){0.f, 0.f, 0.f, 0.f};
        cur = nxt; cA = nA; cB = nB; ++ui;
        if constexpr (ALIGN_EPI) { if (wr == 1) PG8_BAR; }
    }
    PG8_WAIT_V(0);
    if constexpr (!ALIGN_EPI) { if (wr == 0) PG8_BAR; }
    PG8_BAR;
#undef PG8_SA
#undef PG8_SB
#undef PG8_STAGE
#undef PG8_LDA
#undef PG8_LDB
#undef PG8_MMA
#undef PG8_WAIT_V
#undef PG8_WAIT_L
#undef PG8_BAR
#undef PG8_SCHED
}

struct EpiInProj {
    static constexpr bool PERM = true;
    bf16* P; int pn_off; float ascale;
    __device__ __forceinline__ void operator()(const f32x4 (&acc)[2][2][4][2], const Unit& u, int wr, int wc, int fr, int fq) const {
        const int pn = u.pn + pn_off, pm = u.pm;
        const int row0 = pm * BM + wr * 64 + fr, col0 = pn * BM + wc * 32 + 8 * fq;
        int kind = pn < 4 ? 0 : (pn < 12 ? 1 : (pn < 20 ? 2 : (pn < 24 ? 0 : 3)));
        if (kind == 2 && pm >= MLAT / BM) kind = 0;
        if (kind == 2) {
            const float sgn = (fq < 2) ? -1.f : 1.f;
            float fi[8];
#pragma unroll
            for (int i = 0; i < 8; ++i) fi[i] = __builtin_amdgcn_exp2f(-(float)(8 * (fq & 1) + i) * 0.83048202372184059f) * 0.15915494309189535f;
#pragma unroll
            for (int ai = 0; ai < 2; ++ai)
#pragma unroll
                for (int m = 0; m < 4; ++m) {
                    const int row = row0 + ai * HALF + m * 16, s = row & (SEQ - 1);
                    const float pos = (float)((wc & 1) ? (s & 63) : (s >> 6));
                    float cs[8], sn[8];
#pragma unroll
                    for (int i = 0; i < 8; ++i) { float rev = pos * fi[i]; rev = rev - __builtin_floorf(rev); cs[i] = __builtin_amdgcn_cosf(rev); sn[i] = __builtin_amdgcn_sinf(rev); }
                    bf16* rowp = P + (size_t)row * INW + col0;
#pragma unroll
                    for (int bj = 0; bj < 2; ++bj) {
                        float v[8], o[8];
#pragma unroll
                        for (int i = 0; i < 4; ++i) { v[i] = acc[ai][bj][m][0][i] * ascale; v[4 + i] = acc[ai][bj][m][1][i] * ascale; }
#pragma unroll
                        for (int i = 0; i < 8; ++i) { const float pr = __shfl_xor(v[i], 32); o[i] = v[i] * cs[i] + sgn * pr * sn[i]; }
                        u32x4 w; w.x = cvt_pk_bf16(o[0], o[1]); w.y = cvt_pk_bf16(o[2], o[3]); w.z = cvt_pk_bf16(o[4], o[5]); w.w = cvt_pk_bf16(o[6], o[7]);
                        *(u32x4*)(rowp + bj * HALF) = w;
                    }
                }
        } else {
#pragma unroll
            for (int ai = 0; ai < 2; ++ai)
#pragma unroll
                for (int m = 0; m < 4; ++m) { bf16* rowp = P + (size_t)(row0 + ai * HALF + m * 16) * INW + col0;
#pragma unroll
                    for (int bj = 0; bj < 2; ++bj) { f32x4 v0 = acc[ai][bj][m][0] * ascale, v1 = acc[ai][bj][m][1] * ascale;
                        if (kind == 1) {
#pragma unroll
                            for (int i = 0; i < 4; ++i) { v0[i] = gelu_tanh_f(v0[i]); v1[i] = gelu_tanh_f(v1[i]); } }
                        else if (kind == 3) {
#pragma unroll
                            for (int i = 0; i < 4; ++i) { v0[i] = sigmoid_f(v0[i]); v1[i] = sigmoid_f(v1[i]); } }
                        u32x4 w; w.x = cvt_pk_bf16(v0[0], v0[1]); w.y = cvt_pk_bf16(v0[2], v0[3]); w.z = cvt_pk_bf16(v1[0], v1[1]); w.w = cvt_pk_bf16(v1[2], v1[3]);
                        *(u32x4*)(rowp + bj * HALF) = w; } }
        }
    }
};
struct EpiScaleBf16 {
    static constexpr bool PERM = true;
    bf16* O; int ldc; const float* scale;
    __device__ __forceinline__ void operator()(const f32x4 (&acc)[2][2][4][2], const Unit& u, int wr, int wc, int fr, int fq) const {
        const int row0 = u.pm * BM + wr * 64 + fr, col0 = u.pn * BM + wc * 32 + 8 * fq;
        f32x4 sv[2][2];
#pragma unroll
        for (int bj = 0; bj < 2; ++bj)
#pragma unroll
            for (int n = 0; n < 2; ++n) sv[bj][n] = *(const f32x4*)(scale + col0 + bj * HALF + 4 * n);
#pragma unroll
        for (int ai = 0; ai < 2; ++ai)
#pragma unroll
            for (int m = 0; m < 4; ++m) { bf16* rowp = O + (size_t)(row0 + ai * HALF + m * 16) * ldc + col0;
#pragma unroll
                for (int bj = 0; bj < 2; ++bj) { const f32x4 v0 = acc[ai][bj][m][0] * sv[bj][0], v1 = acc[ai][bj][m][1] * sv[bj][1];
                    u32x4 w; w.x = cvt_pk_bf16(v0[0], v0[1]); w.y = cvt_pk_bf16(v0[2], v0[3]); w.z = cvt_pk_bf16(v1[0], v1[1]); w.w = cvt_pk_bf16(v1[2], v1[3]);
                    *(u32x4*)(rowp + bj * HALF) = w; } }
    }
};
struct EpiMerge {
    static constexpr bool PERM = true;
    const bf16* Pg;
    bf16* O;
    __device__ __forceinline__ void scale(f32x4 (&acc)[2][2][4][2], const Unit& u, int seg, int wr, int wc, int fr, int fq) const {
        int row0 = u.pm * BM + wr * 64 + fr; const int col0 = u.pn * BM + wc * 32 + 8 * fq;
        asm volatile("" : "+v"(row0));
        const bf16* gn = Pg + (size_t)(seg - 1) * DM + col0; const bf16* gd = Pg + (size_t)seg * DM + col0;
#pragma unroll
        for (int ai = 0; ai < 2; ++ai) {
#pragma unroll
            for (int m = 0; m < 4; ++m) { const size_t ro = (size_t)(row0 + ai * HALF + m * 16) * INW;
#pragma unroll
                for (int bj = 0; bj < 2; ++bj) { const u32x4 a = *(const u32x4*)(gn + ro + bj * HALF), b = *(const u32x4*)(gd + ro + bj * HALF);
                    f32x4 r0, r1;
                    r0[0] = bf_lo(a.x) * __builtin_amdgcn_rcpf(bf_lo(b.x)); r0[1] = bf_hi(a.x) * __builtin_amdgcn_rcpf(bf_hi(b.x));
                    r0[2] = bf_lo(a.y) * __builtin_amdgcn_rcpf(bf_lo(b.y)); r0[3] = bf_hi(a.y) * __builtin_amdgcn_rcpf(bf_hi(b.y));
                    r1[0] = bf_lo(a.z) * __builtin_amdgcn_rcpf(bf_lo(b.z)); r1[1] = bf_hi(a.z) * __builtin_amdgcn_rcpf(bf_hi(b.z));
                    r1[2] = bf_lo(a.w) * __builtin_amdgcn_rcpf(bf_lo(b.w)); r1[3] = bf_hi(a.w) * __builtin_amdgcn_rcpf(bf_hi(b.w));
                    acc[ai][bj][m][0] *= r0; acc[ai][bj][m][1] *= r1; }
                if (m == 3) asm volatile("" ::: "memory"); } }
    }
    __device__ __forceinline__ void operator()(const f32x4 (&acc)[2][2][4][2], const Unit& u, int wr, int wc, int fr, int fq) const {
        int row0 = u.pm * BM + wr * 64 + fr; const int col0 = u.pn * BM + wc * 32 + 8 * fq;
        asm volatile("" : "+v"(row0));
        const bf16* gc = Pg + (size_t)2 * DM + col0;
#pragma unroll
        for (int ai = 0; ai < 2; ++ai)
#pragma unroll
            for (int m = 0; m < 4; ++m) { const size_t r = (size_t)(row0 + ai * HALF + m * 16);
#pragma unroll
                for (int bj = 0; bj < 2; ++bj) { const u32x4 g = *(const u32x4*)(gc + r * INW + bj * HALF); const f32x4 v0 = acc[ai][bj][m][0], v1 = acc[ai][bj][m][1];
                    u32x4 w; w.x = cvt_pk_bf16(v0[0] * bf_lo(g.x), v0[1] * bf_hi(g.x)); w.y = cvt_pk_bf16(v0[2] * bf_lo(g.y), v0[3] * bf_hi(g.y));
                    w.z = cvt_pk_bf16(v1[0] * bf_lo(g.z), v1[1] * bf_hi(g.z)); w.w = cvt_pk_bf16(v1[2] * bf_lo(g.w), v1[3] * bf_hi(g.w));
                    *(u32x4*)(O + r * DM + col0 + bj * HALF) = w; } }
    }
};
struct EpiResid {
    static constexpr bool PERM = false;
    const float* src0; const float* src1; float* out; const float* gate; float ascale;
    __device__ __forceinline__ void operator()(const f32x4 (&acc)[2][2][4][2], const Unit& u, int wr, int wc, int fr, int fq) const {
        const int row0 = u.pm * BM + wr * 64 + fr, col0 = u.pn * BM + wc * 32 + 4 * fq;
        const bool isctx = u.pm >= MLAT / BM;
        const int bidx = isctx ? NB : (u.pm * BM) / SEQ;
        const float* src = isctx ? (src1 - (size_t)MLAT * DM) : src0;
        const float* gp = gate + (size_t)bidx * INW + col0;
        f32x4 gv[2][2];
#pragma unroll
        for (int bj = 0; bj < 2; ++bj)
#pragma unroll
            for (int n = 0; n < 2; ++n) gv[bj][n] = *(const f32x4*)(gp + bj * HALF + n * 16) * ascale;
#pragma unroll
        for (int ai = 0; ai < 2; ++ai)
#pragma unroll
            for (int m = 0; m < 4; ++m) { const size_t off = (size_t)(row0 + ai * HALF + m * 16) * DM + col0;
#pragma unroll
                for (int bj = 0; bj < 2; ++bj)
#pragma unroll
                    for (int n = 0; n < 2; ++n) { const f32x4 xs = *(const f32x4*)(src + off + bj * HALF + n * 16);
                        *(f32x4*)(out + off + bj * HALF + n * 16) = xs + gv[bj][n] * acc[ai][bj][m][n]; }
                if (m == 3) asm volatile("" ::: "memory"); }
    }
};
template <bool IN_F8, bool OUT_F8> struct EpiSwiGLU {
    static constexpr bool PERM = true;
    unsigned char* O; int ldc;
    __device__ __forceinline__ void operator()(const f32x4 (&acc)[2][2][4][2], const Unit& u, int wr, int wc, int fr, int fq) const {
        const int row0 = u.pm * BM + wr * 64 + fr, col0 = u.pn * HALF + wc * 32 + 8 * fq;
        constexpr float si = IN_F8 ? FP8_INV : 1.0f, so = OUT_F8 ? FP8_SA : 1.0f;
#pragma unroll
        for (int ai = 0; ai < 2; ++ai)
#pragma unroll
            for (int m = 0; m < 4; ++m) { f32x4 v0, v1;
#pragma unroll
                for (int i = 0; i < 4; ++i) { const float g0 = acc[ai][0][m][0][i] * si, g1 = acc[ai][0][m][1][i] * si;
                    v0[i] = g0 * sigmoid_f(g0) * (acc[ai][1][m][0][i] * (si * so)); v1[i] = g1 * sigmoid_f(g1) * (acc[ai][1][m][1][i] * (si * so)); }
                const size_t eo = (size_t)(row0 + ai * HALF + m * 16) * ldc + col0;
                if constexpr (OUT_F8) { u32x2 w; w.x = pk4_fp8(v0[0], v0[1], v0[2], v0[3]); w.y = pk4_fp8(v1[0], v1[1], v1[2], v1[3]); *(u32x2*)(O + eo) = w; }
                else { u32x4 w; w.x = cvt_pk_bf16(v0[0], v0[1]); w.y = cvt_pk_bf16(v0[2], v0[3]); w.z = cvt_pk_bf16(v1[0], v1[1]); w.w = cvt_pk_bf16(v1[2], v1[3]); *(u32x4*)(O + 2 * eo) = w; } }
    }
};
struct EpiPartBf16 {
    static constexpr bool PERM = true;
    bf16* Y; size_t part; float ascale;
    __device__ __forceinline__ void operator()(const f32x4 (&acc)[2][2][4][2], const Unit& u, int wr, int wc, int fr, int fq) const {
        const int ks = u.pn >> 3, pnr = u.pn & 7;
        const int row0 = u.pm * BM + wr * 64 + fr, col0 = pnr * BM + wc * 32 + 8 * fq;
        bf16* base = Y + (size_t)ks * part;
#pragma unroll
        for (int ai = 0; ai < 2; ++ai)
#pragma unroll
            for (int m = 0; m < 4; ++m) { bf16* rowp = base + (size_t)(row0 + ai * HALF + m * 16) * DM + col0;
#pragma unroll
                for (int bj = 0; bj < 2; ++bj) { const f32x4 v0 = acc[ai][bj][m][0] * ascale, v1 = acc[ai][bj][m][1] * ascale;
                    u32x4 w; w.x = cvt_pk_bf16(v0[0], v0[1]); w.y = cvt_pk_bf16(v0[2], v0[3]); w.z = cvt_pk_bf16(v1[0], v1[1]); w.w = cvt_pk_bf16(v1[2], v1[3]);
                    *(u32x4*)(rowp + bj * HALF) = w; } }
    }
};
struct EpiF32 {
    static constexpr bool PERM = false;
    float* C; int ldc; float ascale;
    __device__ __forceinline__ void operator()(const f32x4 (&acc)[2][2][4][2], const Unit& u, int wr, int wc, int fr, int fq) const {
        const int row0 = u.pm * BM + wr * 64 + fr, col0 = u.pn * BM + wc * 32 + 4 * fq;
#pragma unroll
        for (int ai = 0; ai < 2; ++ai)
#pragma unroll
            for (int m = 0; m < 4; ++m) { float* rowp = C + (size_t)(row0 + ai * HALF + m * 16) * ldc + col0;
#pragma unroll
                for (int bj = 0; bj < 2; ++bj)
#pragma unroll
                    for (int n = 0; n < 2; ++n) *(f32x4*)(rowp + bj * HALF + n * 16) = acc[ai][bj][m][n] * ascale; }
    }
};
}

namespace att {
constexpr int QBLK = 32, KVBLK = 64, LDP = INW;
constexpr float SCALE = 0.125f, THR = 8.f;
constexpr size_t SHM_V = KVBLK * 128 * 2, SHM_K = KVBLK * 128 * 2;
constexpr int LDS_WS = 2 * SHM_V + 2 * SHM_K;
#define KSWZ(row, colB) ((row) * 256 + ((colB) ^ (((row) & 7) << 4)))
#define SBAR() __builtin_amdgcn_sched_barrier(0)
__device__ __forceinline__ int crow(int r, int hi) { return (r & 3) + 8 * (r >> 2) + 4 * hi; }
__device__ __forceinline__ void partialSM(f32x16& p0, f32x16& p1, float& m_reg, float& mn, float& alpha) {
    constexpr float C = SCALE * 1.4426950408889634f;
    float pmax = p0[0];
#pragma unroll
    for (int r = 1; r < 16; ++r) pmax = fmaxf(pmax, p0[r]);
#pragma unroll
    for (int r = 0; r < 16; ++r) pmax = fmaxf(pmax, p1[r]);
    { auto rr = __builtin_amdgcn_permlane32_swap(__float_as_uint(pmax), __float_as_uint(pmax), false, false);
      pmax = fmaxf(__uint_as_float(rr[0]), __uint_as_float(rr[1])); }
    if (__builtin_expect(__all(pmax - m_reg <= THR / SCALE), 1)) { mn = m_reg; alpha = 1.f; }
    else { mn = fmaxf(m_reg, pmax); alpha = __builtin_amdgcn_exp2f((m_reg - mn) * C); m_reg = mn; }
    const float mnC = -mn * C;
#pragma unroll
    for (int r = 0; r < 16; ++r) p0[r] = fmaf(p0[r], C, mnC);
#pragma unroll
    for (int r = 0; r < 16; ++r) p1[r] = fmaf(p1[r], C, mnC);
#pragma unroll
    for (int r = 0; r < 16; ++r) p0[r] = __builtin_amdgcn_exp2f(p0[r]);
}
__device__ __forceinline__ void finishSM(f32x16& p0, f32x16& p1, float alpha, float& l_reg, bf16x8& pa0, bf16x8& pa1, bf16x8& pa2, bf16x8& pa3) {
#pragma unroll
    for (int r = 0; r < 16; ++r) p1[r] = __builtin_amdgcn_exp2f(p1[r]);
    float ps = 0;
#pragma unroll
    for (int r = 0; r < 16; ++r) ps += p0[r];
#pragma unroll
    for (int r = 0; r < 16; ++r) ps += p1[r];
    { auto rr = __builtin_amdgcn_permlane32_swap(__float_as_uint(ps), __float_as_uint(ps), false, false);
      ps = __uint_as_float(rr[0]) + __uint_as_float(rr[1]); }
    l_reg = l_reg * alpha + ps;
#define PK4(P, BASE, OUT) do { unsigned a0 = cvt_pk_bf16(P[BASE + 0], P[BASE + 1]), a1 = cvt_pk_bf16(P[BASE + 2], P[BASE + 3]);   \
    unsigned b0 = cvt_pk_bf16(P[BASE + 4], P[BASE + 5]), b1 = cvt_pk_bf16(P[BASE + 6], P[BASE + 7]);                              \
    auto r0 = __builtin_amdgcn_permlane32_swap(a0, b0, false, false); auto r1 = __builtin_amdgcn_permlane32_swap(a1, b1, false, false); \
    u32x4 w = {r0[0], r1[0], r0[1], r1[1]}; OUT = *reinterpret_cast<bf16x8*>(&w); } while (0)
    PK4(p0, 0, pa0); PK4(p0, 8, pa1); PK4(p1, 0, pa2); PK4(p1, 8, pa3);
#undef PK4
}
__device__ __forceinline__ void qkt(f32x16& p0, f32x16& p1, const char* Ks, const bf16x8* qr, int r32, int hi, int pair) {
    p0 = f32x16{}; p1 = f32x16{};
#pragma unroll
    for (int d0 = 0; d0 < 4; ++d0) { const int cb = (pair * 64 + d0 * 16 + hi * 8) * 2;
        const bf16x8 b0 = *reinterpret_cast<const bf16x8*>(Ks + KSWZ(r32, cb));
        const bf16x8 b1 = *reinterpret_cast<const bf16x8*>(Ks + KSWZ(32 + r32, cb));
        p0 = __builtin_amdgcn_mfma_f32_32x32x16_bf16(b0, qr[d0], p0, 0, 0, 0);
        p1 = __builtin_amdgcn_mfma_f32_32x32x16_bf16(b1, qr[d0], p1, 0, 0, 0); }
}
__device__ __forceinline__ int v_st(int k, int c) { const int kk = (k & ~0xC) | ((k & 4) << 1) | ((k & 8) >> 1); return ((kk >> 3) * 4 + (c >> 5)) * 512 + ((kk & 7) * 32 + (c & 31)) * 2; }
__device__ __forceinline__ int v_rd_base(int lane) { return ((lane & 3) << 3) | (((lane >> 2) & 3) << 6) | (((lane >> 4) & 1) << 5) | (((lane >> 5) & 1) << 8); }
constexpr int v_rd_off(int d0, int ks, int half) { return d0 * 512 + ks * 4096 + half * 2048; }
template <int OFF> __device__ __forceinline__ s16x4 tr_read(int vb) {
    s16x4 r; asm volatile("ds_read_b64_tr_b16 %0, %1 offset:%2" : "=&v"(r) : "v"(vb), "i"(OFF) : "memory"); return r;
}
template <int D0> __device__ __forceinline__ void pv_one(f32x16& od, int vb, bf16x8 pa0, bf16x8 pa1, bf16x8 pa2, bf16x8 pa3) {
    const s16x4 l0 = tr_read<v_rd_off(D0, 0, 0)>(vb), h0 = tr_read<v_rd_off(D0, 0, 1)>(vb), l1 = tr_read<v_rd_off(D0, 1, 0)>(vb), h1 = tr_read<v_rd_off(D0, 1, 1)>(vb);
    const s16x4 l2 = tr_read<v_rd_off(D0, 2, 0)>(vb), h2 = tr_read<v_rd_off(D0, 2, 1)>(vb), l3 = tr_read<v_rd_off(D0, 3, 0)>(vb), h3 = tr_read<v_rd_off(D0, 3, 1)>(vb);
    asm volatile("s_waitcnt lgkmcnt(0)" ::: "memory"); SBAR();
#define PK(L, H) (bf16x8){L[0], L[1], L[2], L[3], H[0], H[1], H[2], H[3]}
    od = __builtin_amdgcn_mfma_f32_32x32x16_bf16(pa0, PK(l0, h0), od, 0, 0, 0);
    od = __builtin_amdgcn_mfma_f32_32x32x16_bf16(pa1, PK(l1, h1), od, 0, 0, 0);
    od = __builtin_amdgcn_mfma_f32_32x32x16_bf16(pa2, PK(l2, h2), od, 0, 0, 0);
    od = __builtin_amdgcn_mfma_f32_32x32x16_bf16(pa3, PK(l3, h3), od, 0, 0, 0);
#undef PK
}
__device__ __forceinline__ void pv_d0(f32x16* o, int vb, bf16x8 pa0, bf16x8 pa1, bf16x8 pa2, bf16x8 pa3) {
    pv_one<0>(o[0], vb, pa0, pa1, pa2, pa3); pv_one<1>(o[1], vb, pa0, pa1, pa2, pa3); pv_one<2>(o[2], vb, pa0, pa1, pa2, pa3); pv_one<3>(o[3], vb, pa0, pa1, pa2, pa3);
}
__device__ __forceinline__ void diff_attn_unit(const bf16* __restrict__ Qb, const bf16* __restrict__ K0, int nt0, const bf16* __restrict__ K1, int nt1,
                                               bf16* __restrict__ Ob, int ldo, float lam, const float* __restrict__ subg, float gmul, char* lds) {
    int tid = threadIdx.x; asm volatile("" : "+v"(tid));
    const int wid = __builtin_amdgcn_readfirstlane(tid >> 6), lane = tid & 63, r32 = lane & 31, hi = lane >> 5;
    const int pair = wid >> 2, wq = wid & 3;
    char* V_lds = lds; char* K_lds = lds + 2 * SHM_V;
    float* ws = (float*)(lds + LDS_WS) + wid * 64; float* li_l = ws; float* al_l = ws + 32;
    float m_reg = -1e30f, l_reg = 0; f32x16 o[4] = {}; bf16x8 qr[4];
    const bf16* Qw = Qb + (long)(wq * QBLK + r32) * LDP + pair * 64 + hi * 8;
#pragma unroll
    for (int d0 = 0; d0 < 4; ++d0) qr[d0] = *reinterpret_cast<const bf16x8*>(Qw + d0 * 16);
    const int sr = tid >> 4, sc = (tid & 15) * 8, vst0 = v_st(sr, sc), vst1 = v_st(32 + sr, sc);
    const int vb0 = (int)(uintptr_t)V_lds + v_rd_base(lane);
    struct { bf16x8 vs0, vs1, ks0, ks1; } sr_[2];
#define KT(t) (((t) < nt0) ? (K0 + (long)(t) * KVBLK * LDP) : (K1 + (long)((t) - nt0) * KVBLK * LDP))
#define SLOAD(i, t) do { const bf16* kt_ = KT(t); sr_[i].vs0 = *reinterpret_cast<const bf16x8*>(&kt_[(long)sr * LDP + 1024 + sc]); sr_[i].vs1 = *reinterpret_cast<const bf16x8*>(&kt_[(long)(32 + sr) * LDP + 1024 + sc]); \
    sr_[i].ks0 = *reinterpret_cast<const bf16x8*>(&kt_[(long)sr * LDP + sc]); sr_[i].ks1 = *reinterpret_cast<const bf16x8*>(&kt_[(long)(32 + sr) * LDP + sc]); } while (0)
#define SWRITE(b, i) do { *(bf16x8*)(V_lds + (b) * SHM_V + vst0) = sr_[i].vs0; *(bf16x8*)(V_lds + (b) * SHM_V + vst1) = sr_[i].vs1; const int kc = sc * 2; \
    *(bf16x8*)(K_lds + (b) * SHM_K + KSWZ(sr, kc)) = sr_[i].ks0; *(bf16x8*)(K_lds + (b) * SHM_K + KSWZ(32 + sr, kc)) = sr_[i].ks1; } while (0)
#define SWAIT() asm volatile("s_waitcnt vmcnt(4)" ::: "memory")
#define RESC(a) do { if (__any((a) < 1.f)) { if (hi == 0) al_l[r32] = (a); asm volatile("s_waitcnt lgkmcnt(0)" ::: "memory"); \
    _Pragma("unroll") for (int d = 0; d < 4; ++d) _Pragma("unroll") for (int r = 0; r < 16; ++r) o[d][r] *= al_l[crow(r, hi)]; } } while (0)
    f32x16 pA0, pA1, pB0, pB1; float mnA, mnB, alA, alB; bf16x8 pa0, pa1, pa2, pa3; const int NT = nt0 + nt1;
    constexpr int SE = 0, SO = 1;
    SLOAD(SE, 0); asm volatile("s_waitcnt vmcnt(0)" ::: "memory"); SWRITE(0, SE); __syncthreads();
    qkt(pA0, pA1, K_lds, qr, r32, hi, pair); partialSM(pA0, pA1, m_reg, mnA, alA);
    SLOAD(SO, 1); if (2 < NT) SLOAD(SE, 2);
    SWAIT(); SWRITE(1, SO); __syncthreads();
    for (int j = 1; j + 1 < NT; j += 2) {
        SBAR(); qkt(pB0, pB1, K_lds + SHM_K, qr, r32, hi, pair);
        finishSM(pA0, pA1, alA, l_reg, pa0, pa1, pa2, pa3); SBAR();
        SLOAD(SO, (j + 2 < NT) ? (j + 2) : (NT - 1)); SBAR();
        pv_d0(o, vb0, pa0, pa1, pa2, pa3); partialSM(pB0, pB1, m_reg, mnB, alB);
        __syncthreads(); SWAIT(); SWRITE(0, SE);
        RESC(alB); __syncthreads();
        SBAR(); qkt(pA0, pA1, K_lds, qr, r32, hi, pair);
        finishSM(pB0, pB1, alB, l_reg, pa0, pa1, pa2, pa3); SBAR();
        if (j + 3 < NT) SLOAD(SE, j + 3); SBAR();
        pv_d0(o, vb0 + (int)SHM_V, pa0, pa1, pa2, pa3); partialSM(pA0, pA1, m_reg, mnA, alA);
        __syncthreads(); SWAIT(); SWRITE(1, SO);
        RESC(alA); __syncthreads();
    }
    SBAR(); qkt(pB0, pB1, K_lds + SHM_K, qr, r32, hi, pair);
    finishSM(pA0, pA1, alA, l_reg, pa0, pa1, pa2, pa3); SBAR();
    pv_d0(o, vb0, pa0, pa1, pa2, pa3); partialSM(pB0, pB1, m_reg, mnB, alB);
    __syncthreads(); RESC(alB);
    finishSM(pB0, pB1, alB, l_reg, pa0, pa1, pa2, pa3); SBAR();
    pv_d0(o, vb0 + (int)SHM_V, pa0, pa1, pa2, pa3);
    if (hi == 0) li_l[r32] = l_reg; asm volatile("s_waitcnt lgkmcnt(0)" ::: "memory");
    float rli[16];
#pragma unroll
    for (int r = 0; r < 16; ++r) rli[r] = __builtin_amdgcn_rcpf(li_l[crow(r, hi)]);
    asm volatile("s_waitcnt vmcnt(0)" ::: "memory");
    __syncthreads();
    float* X = (float*)lds + wq * (QBLK * 128);
    if (pair == 1) {
#pragma unroll
        for (int r = 0; r < 16; ++r) { const float s = rli[r] * lam;
#pragma unroll
            for (int d0 = 0; d0 < 4; ++d0) X[crow(r, hi) * 128 + d0 * 32 + r32] = o[d0][r] * s; }
    }
    __syncthreads();
    if (pair == 0) {
        float gsub[4];
#pragma unroll
        for (int d0 = 0; d0 < 4; ++d0) gsub[d0] = subg[d0 * 32 + r32] * gmul;
#pragma unroll
        for (int r = 0; r < 16; ++r) { float ss = 0.f;
#pragma unroll
            for (int d0 = 0; d0 < 4; ++d0) { const float v = o[d0][r] * rli[r] - X[crow(r, hi) * 128 + d0 * 32 + r32]; o[d0][r] = v; ss += v * v; }
            ss = row16_sum(ss); ss += __shfl_xor(ss, 16);
            const float rstd = 1.0f / sqrtf(ss * (1.0f / 128.0f) + EPS);
            bf16* orow = Ob + (long)(wq * QBLK + crow(r, hi)) * ldo;
#pragma unroll
            for (int d0 = 0; d0 < 4; ++d0) orow[d0 * 32 + r32] = (bf16)(cvt_pk_bf16(o[d0][r] * rstd * gsub[d0], 0.f) & 0xffffu); }
    }
    __syncthreads();
#undef KT
#undef SLOAD
#undef SWRITE
#undef SWAIT
#undef RESC
}
#undef KSWZ
#undef SBAR
}

#define XB_TMO      128
#define XB_XCNT(j)  (256  + 64 * (j))
#define XB_XSUB(j)  (1280 + 64 * (j))
#define XB_XGEN(j)  (2304 + 64 * (j))
#define XB_TOP      3328
#define XB_TOPGEN   3392
#define XCD_BAR_WORDS 3456
#define XB_SPIN_CAP (1u << 18)
__device__ __forceinline__ unsigned xb_ld(unsigned* p)              { return __hip_atomic_load(p, __ATOMIC_RELAXED, __HIP_MEMORY_SCOPE_AGENT); }
__device__ __forceinline__ unsigned xb_add(unsigned* p, unsigned v) { return __hip_atomic_fetch_add(p, v, __ATOMIC_RELAXED, __HIP_MEMORY_SCOPE_AGENT); }
__device__ __forceinline__ unsigned xb_xcc_id() { return (unsigned)__builtin_amdgcn_s_getreg((3 << 11) | 20) & 0xFu; }
#define XB_SPIN(cond, bar) do { unsigned _sp = 0; while (cond) { __builtin_amdgcn_s_sleep(1); \
    if ((++_sp & 255u) == 0u) { if (xb_ld(&(bar)[XB_TMO])) break; if (_sp > XB_SPIN_CAP) { atomicAdd(&(bar)[XB_TMO], 1u); break; } } } } while (0)
struct XcdBarrier { unsigned* bar; unsigned x; volatile LAS unsigned* st; };
__device__ __forceinline__ XcdBarrier xcd_barrier_post(unsigned* bar, volatile LAS unsigned* st) {
    XcdBarrier b; b.bar = bar; b.x = xb_xcc_id(); b.st = st;
    if (threadIdx.x == 0) (void)xb_add(&bar[XB_XCNT(b.x)], 1u);
    return b;
}
__device__ __forceinline__ void xcd_barrier_complete(unsigned* bar, unsigned x, unsigned& nloc, unsigned& nx) {
    const unsigned G = gridDim.x * gridDim.y * gridDim.z;
    unsigned sum, cnt, mine, sp = 0u;
    for (;;) {
        sum = 0u; cnt = 0u; mine = 0u;
#pragma unroll
        for (unsigned j = 0; j < 16; ++j) { const unsigned c = xb_ld(&bar[XB_XCNT(j)]); sum += c; cnt += (c > 0u) ? 1u : 0u; mine = (j == x) ? c : mine; }
        if (sum == G) break;
        __builtin_amdgcn_s_sleep(1);
        if ((++sp & 255u) == 0u) { if (xb_ld(&bar[XB_TMO])) break; if (sp > XB_SPIN_CAP) { atomicAdd(&bar[XB_TMO], 1u); break; } }
    }
    nloc = mine > 0u ? mine : 1u; nx = cnt > 0u ? cnt : 1u;
}
__device__ __forceinline__ void xcd_barrier(const XcdBarrier& b) {
    asm volatile("s_waitcnt vmcnt(0)" ::: "memory");
    __syncthreads();
    if (threadIdx.x == 0) {
        unsigned* bar = b.bar;
        __builtin_amdgcn_s_waitcnt(0);
        unsigned nloc = b.st[0], nx = b.st[1];
        if (nloc == 0u) { xcd_barrier_complete(bar, b.x, nloc, nx); b.st[0] = nloc; b.st[1] = nx; }
        const unsigned old = xb_add(&bar[XB_XSUB(b.x)], 1u);
        const unsigned gen = old / nloc;
        if (old + 1u == (gen + 1u) * nloc) {
            __builtin_amdgcn_fence(__ATOMIC_RELEASE, "agent");
            asm volatile("s_waitcnt vmcnt(0)" ::: "memory");
            const unsigned og = xb_add(&bar[XB_TOP], 1u);
            const unsigned tg = og / nx;
            if (og + 1u == (tg + 1u) * nx) xb_add(&bar[XB_TOPGEN], 1u);
            else XB_SPIN(xb_ld(&bar[XB_TOPGEN]) == tg, bar);
            __builtin_amdgcn_fence(__ATOMIC_ACQUIRE, "agent");
            xb_add(&bar[XB_XGEN(b.x)], 1u);
            asm volatile("s_waitcnt vmcnt(0)" ::: "memory");
        } else {
            XB_SPIN(xb_ld(&bar[XB_XGEN(b.x)]) == gen, bar);
            __builtin_amdgcn_fence(__ATOMIC_ACQUIRE, "agent");
            asm volatile("s_waitcnt vmcnt(0)" ::: "memory");
        }
    }
    __syncthreads();
}

struct Args { const float* in[31]; float* out; unsigned char* ws; int ph_lo, ph_hi; };
enum { I_X = 0, I_C, I_CTX, I_CCTX, I_WMOD, I_BMOD, I_N1G, I_N2G, I_WIN, I_POOLW, I_POOLS, I_SGUNG, I_SGUW, I_SGUB, I_LQ1, I_LK1, I_LQ2, I_LK2, I_SUBG,
       I_WPA, I_WPB, I_WPC, I_WO, I_FW1, I_FW3, I_FW2, I_ROUTER, I_MW1, I_MW3, I_MW2, I_FNG };

struct Frame {
    LAS unsigned char* lds; unsigned char* ws; const Args* a;
    int tid, lane, wave, vcu, G;
};

__device__ __forceinline__ void frame_refresh(Frame& F) {
    int tid = threadIdx.x; asm volatile("" : "+v"(tid));
    F.tid = tid; F.lane = tid & 63; F.wave = __builtin_amdgcn_readfirstlane(tid >> 6);
}
struct TDesc { const float* src; bf16* dst; int K, N, batch; long sstride, dstride; long dpitch; int koff, mode, f8; unsigned char* dst8; int split; };
__device__ __forceinline__ void get_tdesc(int d, const Args& a, unsigned char* ws, TDesc& t) {
    t.batch = 1; t.sstride = 0; t.dstride = 0; t.koff = 0; t.mode = 0; t.f8 = 0; t.dst8 = nullptr; t.split = 1 << 30;
    switch (d) {
    case 0: t.src = a.in[I_WIN]; t.dst = (bf16*)(ws + WS_WIN); t.K = DM; t.N = INW; t.batch = 2; t.sstride = (long)DM * INW; t.dstride = (long)INW * DM; t.dpitch = DM; t.dst8 = ws + WS_WIN8; t.split = F8_GATES ? IN_SPLIT : (1 << 30); break;
    case 1: t.src = a.in[I_WPA]; t.dst = (bf16*)(ws + WS_WPC); t.K = 1024; t.N = DM; t.batch = 2; t.sstride = 1024L * DM; t.dstride = 2048L * 3072; t.dpitch = 3072; t.koff = 0; break;
    case 2: t.src = a.in[I_WPB]; t.dst = (bf16*)(ws + WS_WPC); t.K = 1024; t.N = DM; t.batch = 2; t.sstride = 1024L * DM; t.dstride = 2048L * 3072; t.dpitch = 3072; t.koff = 1024; break;
    case 3: t.src = a.in[I_WPC]; t.dst = (bf16*)(ws + WS_WPC); t.K = 1024; t.N = DM; t.batch = 2; t.sstride = 1024L * DM; t.dstride = 2048L * 3072; t.dpitch = 3072; t.koff = 2048; break;
    case 4: t.src = a.in[I_WO]; t.dst = (bf16*)(ws + WS_WO); t.K = DM; t.N = DM; t.batch = 2; t.sstride = (long)DM * DM; t.dstride = (long)DM * DM; t.dpitch = DM; break;
    case 5: t.src = a.in[I_POOLW]; t.dst = (bf16*)(ws + WS_WPOOL); t.K = 256; t.N = 256; t.batch = 8; t.sstride = 65536; t.dstride = 65536; t.dpitch = 256; break;
    case 6: t.src = a.in[I_FW1]; t.dst = (bf16*)(ws + WS_W13); t.K = DM; t.N = DFF; t.dpitch = DM; t.mode = 1; t.f8 = F8_FFN1; break;
    case 7: t.src = a.in[I_FW3]; t.dst = (bf16*)(ws + WS_W13); t.K = DM; t.N = DFF; t.dpitch = DM; t.mode = 2; t.f8 = F8_FFN1; break;
    case 8: t.src = a.in[I_FW2]; t.dst = (bf16*)(ws + WS_W2); t.K = DFF; t.N = DM; t.dpitch = DFF; t.f8 = F8_FFN2; break;
    case 9: t.src = a.in[I_MW1]; t.dst = (bf16*)(ws + WS_MW13); t.K = DM; t.N = DFE; t.batch = NE; t.sstride = (long)DM * DFE; t.dstride = 2L * DFE * DM; t.dpitch = DM; t.mode = 1; t.f8 = F8_MOE1; break;
    case 10: t.src = a.in[I_MW3]; t.dst = (bf16*)(ws + WS_MW13); t.K = DM; t.N = DFE; t.batch = NE; t.sstride = (long)DM * DFE; t.dstride = 2L * DFE * DM; t.dpitch = DM; t.mode = 2; t.f8 = F8_MOE1; break;
    default: t.src = a.in[I_MW2]; t.dst = (bf16*)(ws + WS_MW2); t.K = DFE; t.N = DM; t.batch = NE; t.sstride = (long)DFE * DM; t.dstride = (long)DM * DFE; t.dpitch = DFE; t.f8 = F8_MOE2; break;
    }
}
constexpr int N_TDESC = 12;
__host__ __device__ constexpr long tdesc_items(int d) {
    return d == 0 ? 2L * 32 * 192 : (d >= 1 && d <= 3) ? 2L * 16 * 32 : d == 4 ? 2L * 32 * 32 : d == 5 ? 8L * 4 * 4 : (d == 6 || d == 7) ? 32L * 88 : d == 8 ? 88L * 32 : (d == 9 || d == 10) ? 8L * 32 * 112 : 8L * 112 * 32;
}
__device__ __forceinline__ void tr_item(const TDesc& t, long item, LAS float* scr, int lane) {
    const int nK = t.K / 64, nN = t.N / 64;
    int nb, kb, bt;
    if ((nK & 7) == 0) { const int k8 = (int)(item & 7); const long r0 = item >> 3; nb = (int)(r0 % nN); const long r1 = r0 / nN; const int kq = (int)(r1 % (nK >> 3)); bt = (int)(r1 / (nK >> 3)); kb = kq * 8 + k8; }
    else { nb = (int)(item % nN); const long r1 = item / nN; kb = (int)(r1 % nK); bt = (int)(r1 / nK); }
    const float* W = t.src + (long)bt * t.sstride; bf16* WT = t.dst + (t.f8 ? 0 : (long)bt * t.dstride); unsigned char* WT8 = (unsigned char*)t.dst + (long)bt * t.dstride;
    const int k0 = kb * 64, n0 = nb * 64;
    f32x4 v[16];
#pragma unroll
    for (int i = 0; i < 16; ++i) v[i] = __builtin_nontemporal_load((const f32x4*)(W + (size_t)(k0 + 4 * i + (lane >> 4)) * t.N + n0 + (lane & 15) * 4));
#pragma unroll
    for (int i = 0; i < 16; ++i) { LAS float* d = scr + (4 * i + (lane >> 4)) * 65 + (lane & 15) * 4; d[0] = v[i][0]; d[1] = v[i][1]; d[2] = v[i][2]; d[3] = v[i][3]; }
    LDS_WAIT();
    const int c = lane & 7;
#pragma unroll
    for (int j = 0; j < 8; ++j) { const int n = (lane >> 3) + 8 * j; const LAS float* s = scr + (8 * c) * 65 + n;
        u32x4 o; o.x = cvt_pk_bf16(s[0 * 65], s[1 * 65]); o.y = cvt_pk_bf16(s[2 * 65], s[3 * 65]); o.z = cvt_pk_bf16(s[4 * 65], s[5 * 65]); o.w = cvt_pk_bf16(s[6 * 65], s[7 * 65]);
        const int ng = n0 + n; const long drow = t.mode == 0 ? (long)ng : ((long)(ng >> 7) * 256 + (t.mode == 2 ? 128 : 0) + (ng & 127));
        if (ng >= t.split) { u32x2 o8; o8.x = pk4_fp8(s[0 * 65] * FP8_SW, s[1 * 65] * FP8_SW, s[2 * 65] * FP8_SW, s[3 * 65] * FP8_SW); o8.y = pk4_fp8(s[4 * 65] * FP8_SW, s[5 * 65] * FP8_SW, s[6 * 65] * FP8_SW, s[7 * 65] * FP8_SW);
            *(u32x2*)(t.dst8 + ((long)bt * (t.N - t.split) + (ng - t.split)) * t.K + k0 + 8 * c) = o8; }
        else if (t.f8) { u32x2 o8; o8.x = pk4_fp8(s[0 * 65] * FP8_SW, s[1 * 65] * FP8_SW, s[2 * 65] * FP8_SW, s[3 * 65] * FP8_SW); o8.y = pk4_fp8(s[4 * 65] * FP8_SW, s[5 * 65] * FP8_SW, s[6 * 65] * FP8_SW, s[7 * 65] * FP8_SW);
            *(u32x2*)(WT8 + drow * t.dpitch + t.koff + k0 + 8 * c) = o8; }
        else *(u32x4*)(WT + drow * t.dpitch + t.koff + k0 + 8 * c) = o; }
    LDS_WAIT();
}

__device__ __forceinline__ void mod_sil(Frame& F) {
    LAS float* sil = (LAS float*)F.lds; const float* cv = F.a->in[I_C]; const float* cc = F.a->in[I_CCTX];
    for (int idx = F.tid; idx < 5 * DM; idx += 512) { const int j = idx / DM, k = idx % DM; const float c = (j < 4) ? cv[j * DM + k] : cc[k]; sil[idx] = c / (1.0f + __expf(-c)); }
    __syncthreads();
}
__device__ __forceinline__ void mod_unit(Frame& F, int unit) {
    const int l = unit / 384, cb = unit % 384;
    LAS float* sil = (LAS float*)F.lds; LAS float* red = (LAS float*)(F.lds + 40960);
    const int q = F.lane & 7, kg = F.lane >> 3, col0 = cb * 32 + 4 * q, kbase = F.wave * 256 + kg * 32;
    const float* wm = F.a->in[I_WMOD] + ((size_t)l * DM + kbase) * (6 * DM) + col0;
    f32x4 acc[5];
#pragma unroll
    for (int j = 0; j < 5; ++j) acc[j] = (f32x4){0.f, 0.f, 0.f, 0.f};
#pragma unroll 8
    for (int kk = 0; kk < 32; ++kk) { const f32x4 wv = __builtin_nontemporal_load((const f32x4*)(wm + (size_t)kk * (6 * DM)));
#pragma unroll
        for (int j = 0; j < 5; ++j) acc[j] += sil[j * DM + kbase + kk] * wv; }
#pragma unroll
    for (int o = 8; o < 64; o <<= 1)
#pragma unroll
        for (int j = 0; j < 5; ++j)
#pragma unroll
            for (int e = 0; e < 4; ++e) acc[j][e] += __shfl_xor(acc[j][e], o);
    if (kg == 0) {
#pragma unroll
        for (int j = 0; j < 5; ++j) *(LAS f32x4*)(red + (F.wave * 5 + j) * 32 + 4 * q) = acc[j]; }
    __syncthreads();
    float* MOD = (float*)(F.ws + WS_MOD);
    if (F.tid < 5 * 32) { const int j = F.tid / 32, cidx = F.tid % 32; float sum = 0.f;
#pragma unroll
        for (int w = 0; w < 8; ++w) sum += red[(w * 5 + j) * 32 + cidx];
        MOD[((size_t)l * 5 + j) * (6 * DM) + cb * 32 + cidx] = sum + F.a->in[I_BMOD][(size_t)l * (6 * DM) + cb * 32 + cidx]; }
    __syncthreads();
}

template <bool F8OUT = false, bool BOTH = false>
__device__ __forceinline__ void normmod_row(const float* xrow, const float* g, const float* sh, const float* sc, bf16* orow, int lane_, f32x4 (&hv)[8], unsigned char* orow8 = nullptr) {
    int lane = lane_;
    asm volatile("" : "+v"(lane));
    f32x4 v[8]; float ss = 0.f;
#pragma unroll
    for (int j = 0; j < 8; ++j) { v[j] = ((const f32x4*)xrow)[lane + 64 * j]; ss += (v[j][0] * v[j][0] + v[j][1] * v[j][1]) + (v[j][2] * v[j][2] + v[j][3] * v[j][3]); }
    const float rstd = 1.0f / sqrtf(wave_sum(ss) * (1.0f / DM) + EPS);
#pragma unroll
    for (int j = 0; j < 8; ++j) { const int c4 = lane + 64 * j; const f32x4 gg = ((const f32x4*)g)[c4], s1 = ((const f32x4*)sh)[c4], s2 = ((const f32x4*)sc)[c4];
        const f32x4 h = (v[j] * rstd * gg) * (1.0f + s2) + s1; hv[j] = h;
        if constexpr (F8OUT) ((unsigned*)orow)[c4] = pk4_fp8(h[0] * FP8_SA, h[1] * FP8_SA, h[2] * FP8_SA, h[3] * FP8_SA);
        else { u32x2 w; w.x = cvt_pk_bf16(h[0], h[1]); w.y = cvt_pk_bf16(h[2], h[3]); ((u32x2*)orow)[c4] = w; }
        if constexpr (BOTH) ((unsigned*)orow8)[c4] = pk4_fp8(h[0] * FP8_SA, h[1] * FP8_SA, h[2] * FP8_SA, h[3] * FP8_SA);
        if ((j & 3) == 3) asm volatile("" ::: "memory"); }
}

__device__ __forceinline__ float dot2_bf16(unsigned a, unsigned b, float c) {
    typedef __bf16 bf2_t __attribute__((ext_vector_type(2)));
    return __builtin_amdgcn_fdot2_f32_bf16(__builtin_bit_cast(bf2_t, a), __builtin_bit_cast(bf2_t, b), c, false);
}
__device__ __forceinline__ void sgu_unit(Frame& F, int L, int chunk, int g) {
    constexpr int PITCH = 136;
    LAS bf16* Wb = (LAS bf16*)F.lds; LAS bf16* VT = (LAS bf16*)(F.lds + 128 * PITCH * 2); LAS float* stats = (LAS float*)(F.lds + 2 * 128 * PITCH * 2);
    const bf16* P = (const bf16*)(F.ws + WS_P); bf16* CAT = (bf16*)(F.ws + WS_CAT);
    const int r0 = chunk * 128, tid = F.tid, lane = F.lane, wave = F.wave;
    const float* Wsrc = F.a->in[I_SGUW] + ((size_t)L * 8 + g) * 16384;
    f32x4 wreg[8];
#pragma unroll
    for (int i = 0; i < 8; ++i) wreg[i] = *(const f32x4*)(Wsrc + (size_t)(tid + 512 * i) * 4);
    const bf16* vp2 = P + (size_t)(r0 + 2 * lane) * INW + OFF_B + 1024 + g * 128 + wave * 16;
    const u32x4 v00 = *(const u32x4*)vp2, v01 = *(const u32x4*)(vp2 + 8), v10 = *(const u32x4*)(vp2 + INW), v11 = *(const u32x4*)(vp2 + INW + 8);
    {
        u32x4 a[16], b[16];
#pragma unroll
        for (int rr = 0; rr < 16; ++rr) { const bf16* vp = P + (size_t)(r0 + wave * 16 + rr) * INW + OFF_B + 1024; a[rr] = *(const u32x4*)(vp + lane * 8); b[rr] = *(const u32x4*)(vp + 512 + lane * 8); }
#pragma unroll
        for (int rr = 0; rr < 16; ++rr) {
            constexpr unsigned ONE2 = 0x3f803f80u;
            float sx = 0.f, sq = 0.f;
            sx = dot2_bf16(a[rr].x, ONE2, sx); sx = dot2_bf16(a[rr].y, ONE2, sx); sx = dot2_bf16(a[rr].z, ONE2, sx); sx = dot2_bf16(a[rr].w, ONE2, sx);
            sx = dot2_bf16(b[rr].x, ONE2, sx); sx = dot2_bf16(b[rr].y, ONE2, sx); sx = dot2_bf16(b[rr].z, ONE2, sx); sx = dot2_bf16(b[rr].w, ONE2, sx);
            sq = dot2_bf16(a[rr].x, a[rr].x, sq); sq = dot2_bf16(a[rr].y, a[rr].y, sq); sq = dot2_bf16(a[rr].z, a[rr].z, sq); sq = dot2_bf16(a[rr].w, a[rr].w, sq);
            sq = dot2_bf16(b[rr].x, b[rr].x, sq); sq = dot2_bf16(b[rr].y, b[rr].y, sq); sq = dot2_bf16(b[rr].z, b[rr].z, sq); sq = dot2_bf16(b[rr].w, b[rr].w, sq);
            const float mu = wave_sum(sx) * (1.0f / 1024.0f);
            const float var = fmaxf(wave_sum(sq) * (1.0f / 1024.0f) - mu * mu, 0.f);
            const float rstd = 1.0f / sqrtf(var + EPS);
            const int row = wave * 16 + rr;
            if (lane == 0) { stats[2 * row] = mu; stats[2 * row + 1] = rstd; } } }
#pragma unroll
    for (int i = 0; i < 8; ++i) { const int i4 = tid + 512 * i; const f32x4 w = wreg[i]; const int p = i4 >> 5, q = (i4 & 31) * 4;
        u32x2 o; o.x = cvt_pk_bf16(w[0], w[1]); o.y = cvt_pk_bf16(w[2], w[3]); *(LAS u32x2*)(Wb + p * PITCH + q) = o; }
    __syncthreads();
    { const f32x4 st = *(const LAS f32x4*)(stats + 4 * lane);
      const float* ng = F.a->in[I_SGUNG] + (size_t)L * 1024 + g * 128 + wave * 16;
      LAS unsigned* VT32 = (LAS unsigned*)VT;
      const unsigned x0[8] = {v00.x, v00.y, v00.z, v00.w, v01.x, v01.y, v01.z, v01.w}, x1[8] = {v10.x, v10.y, v10.z, v10.w, v11.x, v11.y, v11.z, v11.w};
#pragma unroll
      for (int e = 0; e < 8; ++e) {
          const float g0 = ng[2 * e], g1 = ng[2 * e + 1];
          VT32[(wave * 16 + 2 * e) * (PITCH / 2) + lane]     = cvt_pk_bf16((bf_lo(x0[e]) - st[0]) * st[1] * g0, (bf_lo(x1[e]) - st[2]) * st[3] * g0);
          VT32[(wave * 16 + 2 * e + 1) * (PITCH / 2) + lane] = cvt_pk_bf16((bf_hi(x0[e]) - st[0]) * st[1] * g1, (bf_hi(x1[e]) - st[2]) * st[3] * g1); } }
    __syncthreads();
    const int fr = lane & 15, fq = lane >> 4;
    f32x4 acc[8];
#pragma unroll
    for (int nb = 0; nb < 8; ++nb) acc[nb] = (f32x4){0.f, 0.f, 0.f, 0.f};
#pragma unroll
    for (int k0 = 0; k0 < 4; ++k0) { const bf16x8 af = *(const LAS bf16x8*)(Wb + (wave * 16 + fr) * PITCH + k0 * 32 + fq * 8);
#pragma unroll
        for (int nb = 0; nb < 8; ++nb) { const bf16x8 bf = *(const LAS bf16x8*)(VT + (nb * 16 + fr) * PITCH + k0 * 32 + fq * 8);
            acc[nb] = __builtin_amdgcn_mfma_f32_16x16x32_bf16(bf, af, acc[nb], 0, 0, 0); } }
    { const int p = wave * 16 + fr; const float bias = F.a->in[I_SGUB][((size_t)L * 8 + g) * 128 + p];
      const bf16* up = P + (size_t)(r0 + p) * INW + OFF_B + g * 128; bf16* op = CAT + (size_t)(r0 + p) * 3072 + 1024 + g * 128;
#pragma unroll
      for (int nb = 0; nb < 8; ++nb) { const int c = nb * 16 + 4 * fq; const u32x2 uu = *(const u32x2*)(up + c);
          u32x2 o; o.x = cvt_pk_bf16((acc[nb][0] + bias) * bf_lo(uu.x), (acc[nb][1] + bias) * bf_hi(uu.x)); o.y = cvt_pk_bf16((acc[nb][2] + bias) * bf_lo(uu.y), (acc[nb][3] + bias) * bf_hi(uu.y));
          *(u32x2*)(op + c) = o; } }
    __syncthreads();
}

template <int HW> __device__ __forceinline__ void pool_block(const bf16* P, bf16* PO, int sb, int slen, int s0, int c) {
    constexpr int NR = 16 + 2 * HW - 1;
    u32x4 r[NR];
#pragma unroll
    for (int k = 0; k < NR; ++k) { const int pos = s0 - HW + k; r[k] = (u32x4){0u, 0u, 0u, 0u}; if (pos >= 0 && pos < slen) r[k] = *(const u32x4*)(P + (size_t)(sb + pos) * INW + c); }
    float sum[8] = {0.f, 0.f, 0.f, 0.f, 0.f, 0.f, 0.f, 0.f};
#define POOL_ACC(SGN, R) do { sum[0] += SGN bf_lo(R.x); sum[1] += SGN bf_hi(R.x); sum[2] += SGN bf_lo(R.y); sum[3] += SGN bf_hi(R.y); sum[4] += SGN bf_lo(R.z); sum[5] += SGN bf_hi(R.z); sum[6] += SGN bf_lo(R.w); sum[7] += SGN bf_hi(R.w); } while (0)
#pragma unroll
    for (int k = 0; k < 2 * HW - 1; ++k) POOL_ACC(+, r[k]);
#pragma unroll
    for (int i = 0; i < 16; ++i) { POOL_ACC(+, r[i + 2 * HW - 1]);
        const int s = s0 + i, lo = (s - HW) < 0 ? 0 : (s - HW), hi = (s + HW) > slen ? slen : (s + HW); const float inv = 1.0f / (float)(hi - lo); const u32x4 a = r[i + HW];
        u32x4 o; o.x = cvt_pk_bf16(sum[0] * inv - bf_lo(a.x), sum[1] * inv - bf_hi(a.x)); o.y = cvt_pk_bf16(sum[2] * inv - bf_lo(a.y), sum[3] * inv - bf_hi(a.y));
        o.z = cvt_pk_bf16(sum[4] * inv - bf_lo(a.z), sum[5] * inv - bf_hi(a.z)); o.w = cvt_pk_bf16(sum[6] * inv - bf_lo(a.w), sum[7] * inv - bf_hi(a.w));
        *(u32x4*)(PO + (size_t)(sb + s) * 1024 + c) = o;
        POOL_ACC(-, r[i]); }
#undef POOL_ACC
}
__device__ __forceinline__ void pooled_items(Frame& F, int Mrows) {
    const bf16* P = (const bf16*)(F.ws + WS_P); bf16* PO = (bf16*)(F.ws + WS_POOLED);
    const int nwi = (Mrows / 32) * 4;
    for (int wi = F.vcu * NWAVES + F.wave; wi < nwi; wi += F.G * NWAVES) {
        const int g = wi & 3, rblk = (wi >> 2) * 2 + (F.lane >> 5), r0 = rblk * 16, c = g * 256 + (F.lane & 31) * 8;
        int sb, s0, slen; if (r0 < MLAT) { sb = r0 & ~(SEQ - 1); s0 = r0 & (SEQ - 1); slen = SEQ; } else { const int rr = r0 - MLAT; sb = MLAT + (rr & ~(CTXL - 1)); s0 = rr & (CTXL - 1); slen = CTXL; }
        if (g == 0) pool_block<1>(P, PO, sb, slen, s0, c); else if (g == 1) pool_block<2>(P, PO, sb, slen, s0, c); else if (g == 2) pool_block<4>(P, PO, sb, slen, s0, c); else pool_block<8>(P, PO, sb, slen, s0, c);
    }
}

struct QSeg { int d; int lo; int n; };
constexpr int NQSEG = 15;
__host__ __device__ constexpr QSeg qseg(int i) {
    return i == 0 ? QSeg{0, 0, 6144} : i == 1 ? QSeg{5, 0, 64} : i == 2 ? QSeg{1, 0, 512} : i == 3 ? QSeg{2, 0, 512} : i == 4 ? QSeg{3, 0, 512} : i == 5 ? QSeg{4, 0, 1024} :
           i == 6 ? QSeg{6, 0, 2816} : i == 7 ? QSeg{7, 0, 2816} : i == 8 ? QSeg{8, 0, 2816} :
           i == 9 ? QSeg{0, 6144, 6144} : i == 10 ? QSeg{5, 64, 64} : i == 11 ? QSeg{1, 512, 512} : i == 12 ? QSeg{2, 512, 512} : i == 13 ? QSeg{3, 512, 512} : i == 14 ? QSeg{4, 1024, 1024} :
           QSeg{0, 0, 0};
}
constexpr int Q_L0MIX = 6144 + 64 + 3 * 512 + 1024, Q_FFN = Q_L0MIX + 3 * 2816, Q_L1MIX = Q_FFN + Q_L0MIX, Q_MOE1 = Q_L1MIX + 2 * 28672, Q_TOTAL = Q_MOE1 + 28672;
constexpr int CW_QCUR = 8192, CW_QDONE = 8256;
__device__ __forceinline__ void q_item(const Args& a, unsigned char* ws, int gi, LAS float* scr, int lane) {
    if (gi >= Q_TOTAL) return;
    int d, it;
    if (gi >= Q_L1MIX) { const int r = gi - Q_L1MIX; d = 9 + r / 28672; it = r % 28672; }
    else { int acc = 0; d = 0; it = 0;
#pragma unroll
        for (int i = 0; i < NQSEG; ++i) { const QSeg q = qseg(i); if (gi >= acc && gi < acc + q.n) { d = q.d; it = q.lo + (gi - acc); } acc += q.n; } }
    TDesc t; get_tdesc(d, a, ws, t); tr_item(t, it, scr, lane);
}
template <int QCH> __device__ __forceinline__ void convert_queue(const Args& a, unsigned char* ws, LAS unsigned char* lds, volatile LAS int* MISCw, int limit, int phase, int G) {
    unsigned* ctl = (unsigned*)(ws + WS_CTL); int tid = threadIdx.x; asm volatile("" : "+v"(tid)); const int wave = __builtin_amdgcn_readfirstlane(tid >> 6), lane = tid & 63;
    LAS float* scr = (LAS float*)(lds + wave * 16640);
    unsigned* cur = ctl + CW_QCUR; unsigned* done = ctl + CW_QDONE + 64 * (phase < 0 ? 0 : phase);
#define Q_TAKE(dst) do { int c_ = -1; const bool go_ = (phase < 0) ? ((int)__hip_atomic_load(cur, __ATOMIC_RELAXED, __HIP_MEMORY_SCOPE_AGENT) < limit) \
            : ((int)__hip_atomic_load(done, __ATOMIC_RELAXED, __HIP_MEMORY_SCOPE_AGENT) < G && (int)__hip_atomic_load(cur, __ATOMIC_RELAXED, __HIP_MEMORY_SCOPE_AGENT) < Q_TOTAL); \
        if (go_) c_ = (int)__hip_atomic_fetch_add(cur, (unsigned)QCH, __ATOMIC_RELAXED, __HIP_MEMORY_SCOPE_AGENT); dst = (c_ >= 0 && c_ < Q_TOTAL) ? c_ : -1; } while (0)
    if (phase >= 0 && tid == 0) __hip_atomic_fetch_add(done, 1u, __ATOMIC_RELAXED, __HIP_MEMORY_SCOPE_AGENT);
    if (tid == 0) { int c0; Q_TAKE(c0); MISCw[0] = c0; }
    __syncthreads();
    for (int it = 0;; ++it) {
        const int c = MISCw[it & 1];
        if (c < 0) break;
        int nx = -1; if (tid == 0) Q_TAKE(nx);
#pragma unroll 1
        for (int j = 0; j < QCH / 8; ++j) q_item(a, ws, c + j * 8 + wave, scr, lane);
        if (tid == 0) MISCw[(it + 1) & 1] = nx;
        __syncthreads();
    }
#undef Q_TAKE
    __syncthreads();
}
__device__ __forceinline__ void convert_until(const Args& a, unsigned char* ws, LAS unsigned char* lds, volatile LAS int* MISCw, int limit) { convert_queue<16>(a, ws, lds, MISCw, limit, -1, 0); }
__device__ __forceinline__ void convert_while(const Args& a, unsigned char* ws, LAS unsigned char* lds, volatile LAS int* MISCw, int p, int G) { convert_queue<32>(a, ws, lds, MISCw, 0, p, G); }

constexpr int N_PHASES = 21;
__global__ void __launch_bounds__(NWAVES * 64, 2) fwd_kernel(Args args) {
    extern __shared__ __attribute__((aligned(16))) unsigned char lds_raw[];
    Frame F;
    F.lds = (LAS unsigned char*)lds_raw; F.ws = args.ws; F.a = &args;
    F.tid = threadIdx.x; F.lane = F.tid & 63; F.wave = __builtin_amdgcn_readfirstlane(F.tid >> 6);
    F.G = gridDim.x; { const int bx = blockIdx.x; F.vcu = (F.G % 8 == 0) ? (bx % 8) * (F.G / 8) + bx / 8 : bx; }
    volatile LAS unsigned* MISC = (volatile LAS unsigned*)(F.lds + MISC_OFF);
    LAS int* TILE_E = (LAS int*)(F.lds + MISC_OFF + 64);
    volatile LAS int* QW = (volatile LAS int*)(F.lds + MISC_OFF + 32);
    unsigned* ctl = (unsigned*)(args.ws + WS_CTL);
    if (F.tid < 4) MISC[F.tid] = 0u;
    __syncthreads();
    XcdBarrier bar; bar.bar = ctl + CW_BAR; bar.x = 0; bar.st = nullptr;
    const int lo = args.ph_lo, hi = args.ph_hi;
    if (hi - lo > 1) bar = xcd_barrier_post(ctl + CW_BAR, MISC);
#ifndef PHASE_MASK
#define PHASE_MASK 0xffffffffu
#endif
#define IN(k) ((((PHASE_MASK) >> (k)) & 1u) && lo <= (k) && (k) < hi)
#define SEAM(k) do { if (IN(k) && IN((k) + 1)) xcd_barrier(bar); } while (0)
    const int gw = F.vcu * NWAVES + F.wave, NGW = F.G * NWAVES;
#define WSPTRS unsigned char* ws = args.ws; asm volatile("" : "+s"(ws)); \
    float* MOD = (float*)(ws + WS_MOD); float* X = (float*)(ws + WS_X); bf16* H = (bf16*)(ws + WS_H); bf16* P = (bf16*)(ws + WS_P); bf16* POOLED = (bf16*)(ws + WS_POOLED); bf16* CAT = (bf16*)(ws + WS_CAT); \
    bf16* MERGED = (bf16*)(ws + WS_MERGED); bf16* ACT = (bf16*)(ws + WS_ACT); bf16* ASORT = (bf16*)(ws + WS_ASORT); bf16* ACTS = (bf16*)(ws + WS_ACTS); float* YSORT = (float*)(ws + WS_YSORT); \
    int* TOKE = (int*)(ws + WS_TOK + TOK_E); f32x2* TOKW = (f32x2*)(ws + WS_TOK + TOK_W); int* SLOT = (int*)(ws + WS_TOK + TOK_SLOT); int* CNT = (int*)(ws + WS_TOK + TOK_CNT); int* MINFO = (int*)(ws + WS_TOK + TOK_INFO); \
    (void)MOD; (void)X; (void)H; (void)P; (void)POOLED; (void)CAT; (void)MERGED; (void)ACT; (void)ASORT; (void)ACTS; (void)YSORT; (void)TOKE; (void)TOKW; (void)SLOT; (void)CNT; (void)MINFO;

    if (IN(0)) { WSPTRS
        frame_refresh(F);
        mod_sil(F);
        for (int u = blockIdx.x; u < 128; u += F.G) mod_unit(F, u);
    }
    SEAM(0);

#define LAYER_PHASES(L, PB)                                                                                                                                         \
                                                                       \
    if (IN(PB + 0)) { WSPTRS if (L == 1) convert_until(args, ws, F.lds, QW, Q_L1MIX); frame_refresh(F);                                                                                                                             \
        const int Mrows = MTOT;                                                                                                                                     \
        for (int m = gw; m < Mrows; m += NGW) {                                                                                                                     \
            const float* xrow = (L == 0) ? (m < MLAT ? args.in[I_X] + (size_t)m * DM : args.in[I_CTX] + (size_t)(m - MLAT) * DM) : X + (size_t)m * DM;              \
            const int bidx = m < MLAT ? m / SEQ : NB; const float* md = MOD + ((size_t)L * 5 + bidx) * (6 * DM);                                                    \
            f32x4 hv[8]; normmod_row<false, F8_GATES>(xrow, args.in[I_N1G] + (size_t)L * DM, md, md + DM, H + (size_t)m * DM, F.lane, hv, ws + WS_H8 + (size_t)m * DM); } \
        if (L == 0) {                \
            __syncthreads(); mod_sil(F); for (int u = 128 + blockIdx.x; u < 768; u += F.G) mod_unit(F, u);                                                          \
            convert_until(args, ws, F.lds, QW, 6144); }                                                                                                             \
    }                                                                                                                                                               \
    SEAM(PB + 0);                                                                                                                                                   \
                                                                                                           \
    if (IN(PB + 1)) { WSPTRS                                                                                                                                              \
        pg8::Order S; S.init((L == 0) ? MTOT / 256 : MLAT / 256, INW / 256, F.G, (int)blockIdx.x, H, 256L * DM * 2, (const bf16*)(ws + WS_WIN) + (size_t)L * INW * DM, 256L * DM * 2); \
        if (L == 1 && !F8_QKV) { S.xM0 = MLAT / 256; S.xNm = 8; S.xN0 = OFF_K / 256; S.xCnt = (MCTX / 256) * 8; }                                                   \
        if (F8_GATES) { S.nN = IN_SPLIT / 256; S.nwg = S.nM * S.nN; }                                                    \
        pg8::EpiInProj E{P, 0, 1.0f};                                                                                                                               \
        pg8::gemm_phase<pg8::EpiInProj, pg8::Order, true, false>(F.lds, DM * 2, DM * 2, DM * 2, S, E);                                                              \
        if (F8_GATES) {            \
            pg8::Order S8; S8.init((L == 0) ? MTOT / 256 : MLAT / 256, (INW - IN_SPLIT) / 256, F.G, (L == 0 || F8_QKV) ? F.G - 1 - (int)blockIdx.x : (int)blockIdx.x, ws + WS_H8, 256L * DM, ws + WS_WIN8 + (size_t)L * (INW - IN_SPLIT) * DM, 256L * DM); \
            if (L == 1 && !F8_QKV) S8.skip = (MCTX / 256) * 8;     \
            if (L == 1 && F8_QKV) { S8.xM0 = MLAT / 256; S8.xNm = 8; S8.xN0 = (OFF_K - IN_SPLIT) / 256; S8.xCnt = (MCTX / 256) * 8; }                  \
            pg8::EpiInProj E8{P, IN_SPLIT / 256, FP8_INV};                                                                                                            \
            pg8::gemm_phase<pg8::EpiInProj, pg8::Order, true, false, true>(F.lds, DM, DM, DM, S8, E8); }                                                              \
        convert_while(args, ws, F.lds, QW, PB + 1, F.G);                                                                    \
    }                                                                                                                                                               \
    SEAM(PB + 1);                                                                                                                                                   \
                                                              \
    if (IN(PB + 2)) { WSPTRS if (L == 0) convert_until(args, ws, F.lds, QW, Q_L0MIX); frame_refresh(F);                                                                                                                             \
        float lam; const float lambda_init = (L == 0) ? 0.2f : 0.35550906759f;                                                                                      \
        { float s1 = 0.f, s2 = 0.f; for (int i = 0; i < 64; ++i) { s1 += args.in[I_LQ1][L * 64 + i] * args.in[I_LK1][L * 64 + i]; s2 += args.in[I_LQ2][L * 64 + i] * args.in[I_LK2][L * 64 + i]; } \
          lam = __expf(s1) - __expf(s2) + lambda_init; }                                                                                                            \
        const float* subg = args.in[I_SUBG] + L * 128;                                                                                                              \
        for (int U = F.vcu; U < 512; U += F.G) { const int bh = U >> 4, qb = U & 15, b = bh >> 3, h = bh & 7;                                                       \
            const bf16* Qb = P + (size_t)(b * SEQ + qb * 128) * INW + OFF_Q + h * 128;                                                                              \
            const bf16* K0 = P + (size_t)(b * SEQ) * INW + OFF_K + h * 128; const bf16* K1 = P + (size_t)(MLAT + b * CTXL) * INW + OFF_K + h * 128;                \
            att::diff_attn_unit(Qb, K0, SEQ / 64, K1, CTXL / 64, CAT + (size_t)(b * SEQ + qb * 128) * 3072 + 2048 + h * 128, 3072, lam, subg, 1.0f - lambda_init, (char*)lds_raw); } \
        if (L == 0) { for (int U = F.vcu - (F.G - 64); U < 64; U += F.G) { if (U < 0) continue; const int bh = U >> 1, qb = U & 1, b = bh >> 3, h = bh & 7;                                          \
            const bf16* Qb = P + (size_t)(MLAT + b * CTXL + qb * 128) * INW + OFF_Q + h * 128; const bf16* K1 = P + (size_t)(MLAT + b * CTXL) * INW + OFF_K + h * 128; \
            att::diff_attn_unit(Qb, K1, CTXL / 64, K1, 0, CAT + (size_t)(MLAT + b * CTXL + qb * 128) * 3072 + 2048 + h * 128, 3072, lam, subg, 1.0f - lambda_init, (char*)lds_raw); } } \
        { const int nsgu = ((L == 0) ? MTOT : MLAT) / 128 * 8; for (int U = F.vcu; U < nsgu; U += F.G) sgu_unit(F, L, U >> 3, U & 7); }                              \
        pooled_items(F, (L == 0) ? MTOT : MLAT); __syncthreads(); convert_while(args, ws, F.lds, QW, PB + 2, F.G);                                                  \
    }                                                                                                                                                               \
    SEAM(PB + 2);                                                                                                                                                   \
                                                                        \
    if (IN(PB + 3)) { WSPTRS                                                                                                                                              \
        pg8::Order S; S.init(((L == 0) ? MTOT : MLAT) / 256, 4, F.G, (int)blockIdx.x, POOLED, 256L * 1024 * 2, (const bf16*)(ws + WS_WPOOL) + (size_t)L * 4 * 65536, 65536L * 2); S.aPn = 256 * 2; \
        pg8::EpiScaleBf16 E{CAT, 3072, args.in[I_POOLS] + (size_t)L * 1024};                                                                                        \
        int Kp = 512; asm volatile("" : "+s"(Kp));                                                    \
        pg8::gemm_phase<pg8::EpiScaleBf16, pg8::Order, false, false>(F.lds, Kp, 2048, 512, S, E);                                                                   \
    }                                                                                                                                                               \
    SEAM(PB + 3);                                                                                                                                                   \
                                                                        \
    if (IN(PB + 4)) { WSPTRS                                                                                                                                              \
        pg8::Order S; S.init(((L == 0) ? MTOT : MLAT) / 256, DM / 256, F.G, (int)blockIdx.x, CAT, 256L * 3072 * 2, (const bf16*)(ws + WS_WPC) + (size_t)L * 2048 * 3072, 256L * 3072 * 2); \
        pg8::EpiMerge E{P + OFF_G, MERGED};                                                                                                                         \
        pg8::gemm_phase<pg8::EpiMerge, pg8::Order, true, true>(F.lds, 6144, 6144, 6144, S, E); convert_while(args, ws, F.lds, QW, PB + 4, F.G);                                                                     \
    }                                                                                                                                                               \
    SEAM(PB + 4);                                                                                                                                                   \
                                                                                           \
    if (IN(PB + 5)) { WSPTRS                                                                                                                                              \
        pg8::Order S; S.init(((L == 0) ? MTOT : MLAT) / 256, DM / 256, F.G, (int)blockIdx.x, MERGED, 256L * DM * 2, (const bf16*)(ws + WS_WO) + (size_t)L * DM * DM, 256L * DM * 2); \
        pg8::EpiResid E{(L == 0) ? args.in[I_X] : X, (L == 0) ? args.in[I_CTX] : X + (size_t)MLAT * DM, X, MOD + (size_t)L * 5 * (6 * DM) + 2 * DM, 1.0f};          \
        pg8::gemm_phase<pg8::EpiResid, pg8::Order, true, false>(F.lds, DM * 2, DM * 2, DM * 2, S, E); convert_while(args, ws, F.lds, QW, PB + 5, F.G);                                                              \
    }                                                                                                                                                               \
    SEAM(PB + 5);

    LAYER_PHASES(0, 1)
    if (IN(7)) { WSPTRS
        convert_until(args, ws, F.lds, QW, Q_FFN);
        frame_refresh(F);
        for (int m = gw; m < MTOT; m += NGW) { const int bidx = m < MLAT ? m / SEQ : NB; const float* md = MOD + ((size_t)0 * 5 + bidx) * (6 * DM);
            f32x4 hv[8]; normmod_row<F8_FFN1>(X + (size_t)m * DM, args.in[I_N2G], md + 3 * DM, md + 4 * DM, (bf16*)((unsigned char*)H + (size_t)m * DM * (F8_FFN1 ? 1 : 2)), F.lane, hv); }
    }
    SEAM(7);
    if (IN(8)) { WSPTRS
        constexpr int es = F8_FFN1 ? 1 : 2;
        pg8::Order S; S.init(MTOT / 256, 2 * DFF / 256, F.G, (int)blockIdx.x, H, 256L * DM * es, ws + WS_W13, 256L * DM * es);
        pg8::EpiSwiGLU<F8_FFN1, F8_FFN2> E{(unsigned char*)ACT, DFF};
        pg8::gemm_phase<pg8::EpiSwiGLU<F8_FFN1, F8_FFN2>, pg8::Order, true, false, F8_FFN1>(F.lds, DM * es, DM * es, DM * es, S, E); convert_while(args, ws, F.lds, QW, 8, F.G);
    }
    SEAM(8);
    if (IN(9)) { WSPTRS
        constexpr int es = F8_FFN2 ? 1 : 2;
        pg8::Order S; S.init(MTOT / 256, DM / 256, F.G, (int)blockIdx.x, ACT, 256L * DFF * es, ws + WS_W2, 256L * DFF * es);
        pg8::EpiResid E{X, X + (size_t)MLAT * DM, X, MOD + 5 * DM, F8_FFN2 ? FP8_INV : 1.0f};
        pg8::gemm_phase<pg8::EpiResid, pg8::Order, true, false, F8_FFN2>(F.lds, DFF * es, DFF * es, DFF * es, S, E); convert_while(args, ws, F.lds, QW, 9, F.G);
    }
    SEAM(9);

    LAYER_PHASES(1, 10)
    const int TPB = (MLAT + F.G - 1) / F.G;
    if (IN(16)) { WSPTRS frame_refresh(F);
        LAS float* wrT = (LAS float*)F.lds;
        LAS int* tokl = (LAS int*)(F.lds + 65536);
        for (int idx = F.tid; idx < DM * NE; idx += 512) wrT[(idx & 7) * DM + (idx >> 3)] = args.in[I_ROUTER][idx];
        __syncthreads();
        const int t0 = blockIdx.x * TPB;
        for (int tt = F.wave; tt < TPB; tt += NWAVES) { const int m = t0 + tt; if (m >= MLAT) break;
            const float* md = MOD + ((size_t)1 * 5 + m / SEQ) * (6 * DM);
            f32x4 hv[8]; normmod_row<F8_MOE1>(X + (size_t)m * DM, args.in[I_N2G] + DM, md + 3 * DM, md + 4 * DM, (bf16*)((unsigned char*)H + (size_t)m * DM * (F8_MOE1 ? 1 : 2)), F.lane, hv);
            int ln = F.lane; asm volatile("" : "+v"(ln));
            float b1 = -3.0e38f, b2 = -3.0e38f; int i1 = 0, i2 = 0;
#pragma unroll 1
            for (int e = 0; e < NE; ++e) { float sx = 0.f;
#pragma unroll
                for (int j = 0; j < 8; ++j) { const f32x4 w = *(const LAS f32x4*)(wrT + e * DM + (ln + 64 * j) * 4); sx += (hv[j][0] * w[0] + hv[j][1] * w[1]) + (hv[j][2] * w[2] + hv[j][3] * w[3]); }
                const float lge = wave_sum(sx);
                if (lge > b1) { b2 = b1; i2 = i1; b1 = lge; i1 = e; } else if (lge > b2) { b2 = lge; i2 = e; } }
            const float w1 = 1.0f / (1.0f + __expf(b2 - b1));
            if (F.lane == 0) { TOKE[m] = i1 | (i2 << 8); TOKW[m] = (f32x2){w1, 1.0f - w1}; tokl[tt] = i1 | (i2 << 8); } }
        __syncthreads();
        if (F.tid < NE) { int c = 0; for (int tt = 0; tt < TPB; ++tt) { if (t0 + tt < MLAT) { const int te = tokl[tt]; c += ((te & 255) == F.tid) + ((te >> 8) == F.tid); } } CNT[blockIdx.x * NE + F.tid] = c; }
    }
    SEAM(16);
    if (IN(17)) { WSPTRS convert_until(args, ws, F.lds, QW, Q_MOE1); frame_refresh(F);
        LAS int* cl = (LAS int*)F.lds;
        LAS int* info = (LAS int*)(F.lds + 16384);
        LAS int* tokl = (LAS int*)(F.lds + 32768);
        for (int idx = F.tid; idx < F.G * NE; idx += 512) cl[idx] = CNT[idx];
        if (F.tid < TPB && (int)blockIdx.x * TPB + F.tid < MLAT) tokl[F.tid] = TOKE[blockIdx.x * TPB + F.tid];
        __syncthreads();
        if (F.tid < 64) {
            const int e = F.tid & 7, part = F.tid >> 3; int tot = 0, pre = 0;
            for (int b = part; b < F.G; b += 8) { const int c = cl[b * NE + e]; tot += c; if (b < (int)blockIdx.x) pre += c; }
#pragma unroll
            for (int o = 8; o < 64; o <<= 1) { tot += __shfl_xor(tot, o); pre += __shfl_xor(pre, o); }
            if (part == 0) { info[e] = tot; info[8 + e] = pre; } }
        __syncthreads();
        if (F.tid == 0) { int ts = 0; for (int e = 0; e < NE; ++e) { info[16 + e] = ts; ts += (info[e] + 255) >> 8; }
            if (blockIdx.x == 0) { for (int e = 0; e < NE; ++e) { MINFO[e] = (info[e] + 255) >> 8; MINFO[8 + e] = info[16 + e]; } MINFO[16] = ts; }
            int run[NE];
#pragma unroll
            for (int e = 0; e < NE; ++e) run[e] = 0;
            const int t0 = blockIdx.x * TPB;
            for (int tt = 0; tt < TPB; ++tt) { const int m = t0 + tt; if (m >= MLAT) break; const int te = tokl[tt];
#pragma unroll
                for (int k = 0; k < 2; ++k) { const int e = k ? (te >> 8) : (te & 255); int r = 0;
#pragma unroll
                    for (int ee = 0; ee < NE; ++ee) if (ee == e) { r = run[ee]; run[ee] = r + 1; }
                    const int slot = info[16 + e] * 256 + info[8 + e] + r; info[32 + 2 * tt + k] = slot; SLOT[2 * m + k] = slot; } } }
        __syncthreads();
        { const int t0 = blockIdx.x * TPB;
          constexpr int es = F8_MOE1 ? 1 : 2;
          for (int base = F.wave; base < 2 * TPB; base += NWAVES * 8) {
              u32x4 rw[8][2 * es]; int slot[8];
#pragma unroll
              for (int k = 0; k < 8; ++k) { const int pr = base + NWAVES * k, m = t0 + (pr >> 1); slot[k] = (pr < 2 * TPB && m < MLAT) ? info[32 + pr] : -1;
                  if (slot[k] >= 0) { const u32x4* s = (const u32x4*)((const unsigned char*)H + (size_t)m * DM * es);
#pragma unroll
                      for (int i = 0; i < 2 * es; ++i) rw[k][i] = s[F.lane + 64 * i]; } }
#pragma unroll
              for (int k = 0; k < 8; ++k) if (slot[k] >= 0) { u32x4* d = (u32x4*)((unsigned char*)ASORT + (size_t)slot[k] * DM * es);
#pragma unroll
                  for (int i = 0; i < 2 * es; ++i) d[F.lane + 64 * i] = rw[k][i]; } } }
    }
    SEAM(17);
    if (IN(18) || IN(19)) { WSPTRS
        frame_refresh(F);
        if (F.tid < MOE_TILES) { int e = 0;
#pragma unroll
            for (int ee = 1; ee < NE; ++ee) if (F.tid >= MINFO[8 + ee]) e = ee;
            TILE_E[F.tid] = e; }
        __syncthreads();
    }
    if (IN(18)) { WSPTRS
        constexpr int es = F8_MOE1 ? 1 : 2;
        pg8::Order S; S.init(__builtin_amdgcn_readfirstlane(MINFO[16]), 2 * DFE / 256, F.G, (int)blockIdx.x, ASORT, 256L * DM * es, ws + WS_MW13, 256L * DM * es); S.tileE = TILE_E; S.bExp = 2L * DFE * DM * es;
        pg8::EpiSwiGLU<F8_MOE1, F8_MOE2> E{(unsigned char*)ACTS, DFE};
        pg8::gemm_phase<pg8::EpiSwiGLU<F8_MOE1, F8_MOE2>, pg8::Order, true, false, F8_MOE1>(F.lds, DM * es, DM * es, DM * es, S, E);
        convert_until(args, ws, F.lds, QW, Q_TOTAL);
    }
    SEAM(18);
    if (IN(19)) { WSPTRS
        constexpr int es = F8_MOE2 ? 1 : 2;
        pg8::Order S; S.init(__builtin_amdgcn_readfirstlane(MINFO[16]), 2 * DM / 256, F.G, (int)blockIdx.x, ACTS, 256L * DFE * es, ws + WS_MW2, 256L * DFE * es); S.tileE = TILE_E; S.bExp = (long)DM * DFE * es;
        S.kShift = 3; S.kOff = (long)(DFE / 2) * es;
        pg8::EpiPartBf16 E{(bf16*)YSORT, (size_t)MOE_ROWS * DM, F8_MOE2 ? FP8_INV : 1.0f};
        pg8::gemm_phase<pg8::EpiPartBf16, pg8::Order, true, false, F8_MOE2>(F.lds, (DFE / 2) * es, DFE * es, DFE * es, S, E);
    }
    SEAM(19);
    if (IN(20)) { WSPTRS
        frame_refresh(F);
        for (int m = gw; m < MLAT; m += NGW) {
            int ln = F.lane; asm volatile("" : "+v"(ln));
            const float* gt = MOD + ((size_t)1 * 5 + m / SEQ) * (6 * DM) + 5 * DM; const f32x2 tw = TOKW[m]; const int s0 = SLOT[2 * m], s1 = SLOT[2 * m + 1];
            const f32x4* xr = (const f32x4*)(X + (size_t)m * DM); const bf16* YB = (const bf16*)YSORT; constexpr size_t YP = (size_t)MOE_ROWS * DM;
            const u32x2* y0 = (const u32x2*)(YB + (size_t)s0 * DM); const u32x2* y1 = (const u32x2*)(YB + (size_t)s1 * DM); const u32x2* y2 = (const u32x2*)(YB + YP + (size_t)s0 * DM); const u32x2* y3 = (const u32x2*)(YB + YP + (size_t)s1 * DM);
            f32x4 v[8]; float ss = 0.f;
#pragma unroll
            for (int j = 0; j < 8; ++j) { const int c4 = ln + 64 * j; const u32x2 a0 = y0[c4], a1 = y1[c4], a2 = y2[c4], a3 = y3[c4];
                const f32x4 e0 = (f32x4){bf_lo(a0.x) + bf_lo(a2.x), bf_hi(a0.x) + bf_hi(a2.x), bf_lo(a0.y) + bf_lo(a2.y), bf_hi(a0.y) + bf_hi(a2.y)};
                const f32x4 e1 = (f32x4){bf_lo(a1.x) + bf_lo(a3.x), bf_hi(a1.x) + bf_hi(a3.x), bf_lo(a1.y) + bf_lo(a3.y), bf_hi(a1.y) + bf_hi(a3.y)};
                v[j] = xr[c4] + ((const f32x4*)gt)[c4] * (tw[0] * e0 + tw[1] * e1);
                ss += (v[j][0] * v[j][0] + v[j][1] * v[j][1]) + (v[j][2] * v[j][2] + v[j][3] * v[j][3]); }
            const float rstd = 1.0f / sqrtf(wave_sum(ss) * (1.0f / DM) + EPS);
#pragma unroll
            for (int j = 0; j < 8; ++j) { const int c4 = ln + 64 * j; __builtin_nontemporal_store(v[j] * rstd * ((const f32x4*)args.in[I_FNG])[c4], (f32x4*)(args.out + (size_t)m * DM) + c4); }
        }
    }
#undef IN
#undef SEAM
}

extern "C" void kernel_launch(void* const* d_in, const int* in_sizes, int n_in, void* d_out, int out_size, void* d_ws, size_t ws_size, hipStream_t stream) {
    static int grid = 0;
    if (grid == 0) {
        if (n_in != 31 || out_size != MLAT * DM || ws_size < WS_END) { fprintf(stderr, "kernel_launch: unexpected shapes: n_in %d out %d ws %zu (need %zu)\n", n_in, out_size, ws_size, (size_t)WS_END); grid = -1; return; }
        int dev = 0, cus = 0, per_cu = 0;
        if (hipGetDevice(&dev) != hipSuccess || hipDeviceGetAttribute(&cus, hipDeviceAttributeMultiprocessorCount, dev) != hipSuccess) { grid = -1; return; }
        if (hipFuncSetAttribute((const void*)fwd_kernel, hipFuncAttributeMaxDynamicSharedMemorySize, LDS_BYTES) != hipSuccess) { fprintf(stderr, "kernel_launch: hipFuncSetAttribute failed\n"); grid = -1; return; }
        if (hipOccupancyMaxActiveBlocksPerMultiprocessor(&per_cu, (const void*)fwd_kernel, NWAVES * 64, LDS_BYTES) != hipSuccess || per_cu < 1) fprintf(stderr, "kernel_launch: occupancy query says %d\n", per_cu);
        (void)hipGetLastError();
        grid = cus > 256 ? 256 : cus;
    }
    if (grid < 0) return;
    (void)hipMemsetAsync((char*)d_ws + WS_CTL, 0, CTL_ZERO_BYTES, stream);
    Args a{};
    for (int i = 0; i < 31; ++i) a.in[i] = (const float*)d_in[i];
    a.out = (float*)d_out; a.ws = (unsigned char*)d_ws;
#if defined(PROBE_K)
    a.ph_lo = 0; a.ph_hi = PROBE_K + 1; hipLaunchKernelGGL(fwd_kernel, dim3(grid), dim3(NWAVES * 64), LDS_BYTES, stream, a);
    (void)hipMemsetAsync((char*)d_ws + WS_CTL, 0, CTL_ZERO_BYTES, stream);
    a.ph_lo = PROBE_K; a.ph_hi = N_PHASES; hipLaunchKernelGGL(fwd_kernel, dim3(grid), dim3(NWAVES * 64), LDS_BYTES, stream, a);
#elif MK_N_LAUNCHES == 1
    a.ph_lo = 0; a.ph_hi = N_PHASES;
    hipLaunchKernelGGL(fwd_kernel, dim3(grid), dim3(NWAVES * 64), LDS_BYTES, stream, a);
#else
    for (int p = 0; p < N_PHASES; ++p) { a.ph_lo = p; a.ph_hi = p + 1; hipLaunchKernelGGL(fwd_kernel, dim3(grid), dim3(NWAVES * 64), LDS_BYTES, stream, a); }
#endif
    const hipError_t le = hipPeekAtLastError();
    if (le != hipSuccess) fprintf(stderr, "kernel_launch: launch failed: %s\n", hipGetErrorName(le));
}
```
